# Optimizing an MI355X kernel written in HIP

```python
import jax
import jax.numpy as jnp
from jax import lax
import numpy as np

D_MODEL = 2048
BATCH = 2
SEQ = 16384
DEPTH = 1

CHUNK = 64
MIX_WIDTH = D_MODEL
GMLP_WIDTH = MIX_WIDTH // 2
GMLP_HEAD_DIM = 128
GMLP_HEADS = GMLP_WIDTH // GMLP_HEAD_DIM
GMLP_BLOCK = 128
POOL_WIDTH = MIX_WIDTH - GMLP_WIDTH
POOL_WINDOWS = (2, 4, 8, 16)
POOL_GROUPS = len(POOL_WINDOWS)
POOL_GROUP_DIM = POOL_WIDTH // POOL_GROUPS
IN_PROJ_WIDTH = 2 * GMLP_WIDTH + POOL_WIDTH
N_EXPERTS = 32
TOP_K = 4
EXPERT_DIM = D_MODEL
SWIGLU_ALPHA = 1.702
SWIGLU_LIMIT = 7.0
MOE_BLOCK = 256
RMS_EPS = 1e-5
LN_EPS = 1e-5

kernel_name = 'hybrid_gmlp_pool_moe_adaln_block'


def rms_norm(x, g):
    xf = x.astype(jnp.float32)
    y = xf * lax.rsqrt(jnp.mean(xf * xf, axis=-1, keepdims=True) + RMS_EPS)
    return (y * g.astype(jnp.float32)).astype(x.dtype)


def gmlp_spatial_gating(u, v, ln_g, ln_b, w_s, b_s):
    bsz, seq, _ = u.shape
    n_blk = seq // GMLP_BLOCK
    vh = v.astype(jnp.float32).reshape(bsz, seq, GMLP_HEADS, GMLP_HEAD_DIM)
    mu = jnp.mean(vh, axis=-1, keepdims=True)
    var = jnp.mean(jnp.square(vh - mu), axis=-1, keepdims=True)
    vn = (vh - mu) * lax.rsqrt(var + LN_EPS)
    vn = vn * ln_g.astype(jnp.float32).reshape(GMLP_HEADS, GMLP_HEAD_DIM) + ln_b.astype(jnp.float32).reshape(GMLP_HEADS, GMLP_HEAD_DIM)
    vn = vn.astype(u.dtype).reshape(bsz, n_blk, GMLP_BLOCK, GMLP_HEADS, GMLP_HEAD_DIM)
    chunk_id = jnp.arange(GMLP_BLOCK) // CHUNK
    mask = chunk_id[:, None] >= chunk_id[None, :]
    ws = jnp.where(mask[None], w_s, jnp.zeros((), w_s.dtype))
    mixed = jnp.einsum('hij,bnjhd->bnihd', ws, vn) + b_s.T[None, None, :, :, None]
    return u * mixed.reshape(bsz, seq, GMLP_WIDTH)


def multiscale_pool(p, w_pool, scale):
    bsz, seq, _ = p.shape
    pf = p.astype(jnp.float32).reshape(bsz, seq, POOL_GROUPS, POOL_GROUP_DIM)
    cs = jnp.cumsum(pf, axis=1)
    t1 = jnp.arange(1, seq + 1, dtype=jnp.float32)
    outs = []
    for g, w in enumerate(POOL_WINDOWS):
        csg = cs[:, :, g]
        lag = jnp.pad(csg, ((0, 0), (w, 0), (0, 0)))[:, :seq]
        cnt = jnp.minimum(t1, float(w))[None, :, None]
        outs.append((csg - lag) / cnt - pf[:, :, g])
    pooled = jnp.stack(outs, axis=2).astype(p.dtype)
    y = jnp.einsum('bsgc,gcd->bsgd', pooled, w_pool)
    return y.reshape(bsz, seq, POOL_WIDTH) * scale


def moe_ffn(h, router_w, router_b, w1, b1, w2, b2):
    bsz, seq, d = h.shape
    n_tok = bsz * seq
    hf = h.reshape(n_tok, d)
    logits = hf.astype(jnp.float32) @ router_w.astype(jnp.float32) + router_b.astype(jnp.float32)
    top_val, top_idx = lax.top_k(logits, TOP_K)
    gates = jax.nn.softmax(top_val, axis=-1)
    n_asg = n_tok * TOP_K
    flat_e = top_idx.reshape(n_asg).astype(jnp.int32)
    order = jnp.argsort(flat_e)
    sorted_e = flat_e[order]
    counts = jnp.bincount(flat_e, length=N_EXPERTS).astype(jnp.int32)
    padded = (counts + MOE_BLOCK - 1) // MOE_BLOCK * MOE_BLOCK
    pad_end = jnp.cumsum(padded)
    pad_start = pad_end - padded
    grp_start = jnp.cumsum(counts) - counts
    dest_sorted = pad_start[sorted_e] + (jnp.arange(n_asg, dtype=jnp.int32) - grp_start[sorted_e])
    dest = jnp.zeros((n_asg,), jnp.int32).at[order].set(dest_sorted)
    n_rows = (n_asg + MOE_BLOCK - 1) // MOE_BLOCK * MOE_BLOCK + N_EXPERTS * MOE_BLOCK
    n_blocks = n_rows // MOE_BLOCK
    rows = jnp.zeros((n_rows, d), h.dtype).at[dest].set(jnp.repeat(hf, TOP_K, axis=0))
    block_start = jnp.arange(n_blocks, dtype=jnp.int32) * MOE_BLOCK
    block_e = jnp.minimum(jnp.searchsorted(pad_end, block_start, side='right'), N_EXPERTS - 1).astype(jnp.int32)

    def expert_block(args):
        xb, e = args
        a = xb @ w1[e] + b1[e]
        glu = jnp.minimum(a[:, :EXPERT_DIM], SWIGLU_LIMIT)
        lin = jnp.clip(a[:, EXPERT_DIM:], -SWIGLU_LIMIT, SWIGLU_LIMIT)
        act = glu * jax.nn.sigmoid(SWIGLU_ALPHA * glu) * (lin + 1.0)
        return act @ w2[e] + b2[e]

    out_rows = lax.map(expert_block, (rows.reshape(n_blocks, MOE_BLOCK, d), block_e)).reshape(n_rows, d)
    out = out_rows[dest].reshape(n_tok, TOP_K, d)
    y = jnp.einsum('tk,tkd->td', gates.astype(h.dtype), out)
    return y.reshape(bsz, seq, d)


def setup_inputs(seed: int = 0) -> dict:
    key = jax.random.key(seed)
    ks = jax.random.split(key, 24)
    f32 = jnp.float32
    L, D, F, E = DEPTH, D_MODEL, EXPERT_DIM, N_EXPERTS

    def nrm(k, shape, s):
        return jax.random.normal(k, shape, f32) * s

    return {
        'x': nrm(ks[0], (BATCH, SEQ, D), 1.0),
        'c': nrm(ks[1], (BATCH, D), 1.0),
        'mix_norm_g': 1.0 + nrm(ks[2], (L, D), 0.02),
        'w_ada': nrm(ks[3], (L, D, 6 * D), D ** -0.5),
        'b_ada': nrm(ks[4], (L, 6 * D), 0.02),
        'w_in': nrm(ks[5], (L, D, IN_PROJ_WIDTH), D ** -0.5),
        'gmlp_ln_g': 1.0 + nrm(ks[6], (L, GMLP_WIDTH), 0.02),
        'gmlp_ln_b': nrm(ks[7], (L, GMLP_WIDTH), 0.02),
        'gmlp_ws': nrm(ks[8], (L, GMLP_HEADS, GMLP_BLOCK, GMLP_BLOCK), GMLP_BLOCK ** -0.5),
        'gmlp_bs': 1.0 + nrm(ks[9], (L, GMLP_HEADS, GMLP_BLOCK), 0.1),
        'pool_w': nrm(ks[10], (L, POOL_GROUPS, POOL_GROUP_DIM, POOL_GROUP_DIM), POOL_GROUP_DIM ** -0.5),
        'pool_scale': 1.0 + nrm(ks[11], (L, POOL_WIDTH), 0.1),
        'gmlp_out_g': 1.0 + nrm(ks[12], (L, GMLP_WIDTH), 0.02),
        'pool_out_g': 1.0 + nrm(ks[13], (L, POOL_WIDTH), 0.02),
        'w_out': nrm(ks[14], (L, MIX_WIDTH, D), MIX_WIDTH ** -0.5),
        'ffn_norm_g': 1.0 + nrm(ks[15], (L, D), 0.02),
        'router_w': nrm(ks[16], (L, D, E), D ** -0.5),
        'router_b': nrm(ks[17], (L, E), 0.01),
        'moe_w1': nrm(ks[18], (L, E, D, 2 * F), D ** -0.5),
        'moe_b1': nrm(ks[19], (L, E, 2 * F), 0.02),
        'moe_w2': nrm(ks[20], (L, E, F, D), F ** -0.5),
        'moe_b2': nrm(ks[21], (L, E, D), 0.02),
        'final_norm_g': 1.0 + nrm(ks[22], (D,), 0.02),
    }


def reference(x, c, mix_norm_g, w_ada, b_ada, w_in, gmlp_ln_g, gmlp_ln_b, gmlp_ws, gmlp_bs, pool_w, pool_scale, gmlp_out_g, pool_out_g, w_out, ffn_norm_g, router_w, router_b, moe_w1, moe_b1, moe_w2, moe_b2, final_norm_g):
    cond = jax.nn.silu(c)
    for l in range(DEPTH):
        mod = (cond @ w_ada[l] + b_ada[l])[:, None, :]
        shift_m, scale_m, gate_m, shift_f, scale_f, gate_f = jnp.split(mod, 6, axis=-1)
        h = rms_norm(x, mix_norm_g[l]) * (1.0 + scale_m) + shift_m
        z = h @ w_in[l]
        u = jax.nn.gelu(z[..., :GMLP_WIDTH], approximate=False)
        v = jax.nn.gelu(z[..., GMLP_WIDTH:2 * GMLP_WIDTH], approximate=False)
        p = z[..., 2 * GMLP_WIDTH:]
        a_out = gmlp_spatial_gating(u, v, gmlp_ln_g[l], gmlp_ln_b[l], gmlp_ws[l], gmlp_bs[l])
        b_out = multiscale_pool(p, pool_w[l], pool_scale[l])
        mixed = jnp.concatenate([rms_norm(a_out, gmlp_out_g[l]), rms_norm(b_out, pool_out_g[l])], axis=-1)
        x = x + gate_m * (mixed @ w_out[l])
        h = rms_norm(x, ffn_norm_g[l]) * (1.0 + scale_f) + shift_f
        x = x + gate_f * moe_ffn(h, router_w[l], router_b[l], moe_w1[l], moe_b1[l], moe_w2[l], moe_b2[l])
    return rms_norm(x, final_norm_g)
```

```cpp
#include <hip/hip_runtime.h>
#include <cstdio>
#include <cstdint>

#ifndef MK_PER_PHASE
#define MK_PER_PHASE 0
#endif

#define GAS __attribute__((address_space(1)))
#define LAS __attribute__((address_space(3)))
typedef unsigned short bf16;
typedef unsigned v4u __attribute__((ext_vector_type(4)));
typedef unsigned v2u __attribute__((ext_vector_type(2)));
typedef float f32x4 __attribute__((ext_vector_type(4)));
typedef float f32x2 __attribute__((ext_vector_type(2)));
typedef short bf16x8 __attribute__((ext_vector_type(8)));

constexpr int NB = 2, SEQ = 16384, T = NB * SEQ, D = 2048, ZW = 3072, NE = 32, TOPK = 4;
constexpr int LCAP = 32768;
constexpr int MAXTILES = T * TOPK / 256 + NE;
constexpr float RMS_EPS = 1e-5f, LN_EPS = 1e-5f;
constexpr int NWAVES = 8, NTHR = 512;

constexpr size_t MiB = 1u << 20;
constexpr size_t WS_CTL = 0, CTL_ZERO_BYTES = 1 * MiB;
constexpr size_t WS_MODP = 1 * MiB;
constexpr size_t WS_MOD = 1 * MiB + 512 * 1024;
constexpr size_t WS_WSB = 2 * MiB;
constexpr size_t WS_PWT = 3 * MiB;
constexpr size_t WS_WIN = 4 * MiB;
constexpr size_t WS_WOUT = 16 * MiB;
constexpr size_t WS_RA = 296 * MiB, WS_RB = 297 * MiB;
constexpr size_t WS_RWP = 298 * MiB;
constexpr size_t WS_LGATE = 288 * MiB;

constexpr size_t WS_LIST = 26 * MiB;
constexpr size_t WS_W1T = 32 * MiB;
constexpr size_t WS_W2T = 544 * MiB;
constexpr size_t WS_H = 800 * MiB;
constexpr size_t WS_H8 = 864 * MiB;
constexpr size_t WS_Z = 928 * MiB;
constexpr size_t WS_MIX = 1120 * MiB;
constexpr size_t WS_X1 = 1248 * MiB;
constexpr size_t WS_ACT = 1504 * MiB;
constexpr size_t WS_Y4 = 2048 * MiB;
constexpr size_t WS_END = 2560 * MiB;
constexpr int CW_BAR = 4096;
constexpr int CW_CNT = 16384;

constexpr int RING_OFF = 0, RING_BYTES = 131072;
constexpr int TAB_OFF = 131072;
constexpr int ROWTAB_OFF = 147456;
constexpr int MOE_OFF = 149504;
constexpr int MISC_OFF = 150016;
constexpr int TBL_OFF = 150528;
constexpr int LDS_BYTES = 156672;

#define LDS_WAIT() asm volatile("s_waitcnt lgkmcnt(0)" ::: "memory")
#define VM_WAIT() asm volatile("s_waitcnt vmcnt(0)" ::: "memory")

__device__ __forceinline__ unsigned cvt_pk_bf16(float lo, float hi) { unsigned r; asm("v_cvt_pk_bf16_f32 %0, %1, %2" : "=v"(r) : "v"(lo), "v"(hi)); return r; }
__device__ __forceinline__ float bf_lo(unsigned w) { return __uint_as_float(w << 16); }
__device__ __forceinline__ float bf_hi(unsigned w) { return __uint_as_float(w & 0xffff0000u); }
__device__ __forceinline__ int lane_id() { int l; asm volatile("v_mbcnt_lo_u32_b32 %0, -1, 0\n\tv_mbcnt_hi_u32_b32 %0, -1, %0" : "=v"(l)); return l; }
__device__ __forceinline__ float wave_sum(float v) {
#pragma unroll
    for (int o = 1; o < 64; o <<= 1) v += __shfl_xor(v, o);
    return v;
}

#define XB_TMO      128
#define XB_XCNT(j)  (256  + 64 * (j))
#define XB_XSUB(j)  (1280 + 64 * (j))
#define XB_XGEN(j)  (2304 + 64 * (j))
#define XB_TOP      3328
#define XB_TOPGEN   3392
#define XCD_BAR_WORDS 3456
#define XB_SPIN_CAP (1u << 18)
__device__ __forceinline__ unsigned xb_ld(unsigned* p)              { return __hip_atomic_load(p, __ATOMIC_RELAXED, __HIP_MEMORY_SCOPE_AGENT); }
__device__ __forceinline__ unsigned xb_add(unsigned* p, unsigned v) { return __hip_atomic_fetch_add(p, v, __ATOMIC_RELAXED, __HIP_MEMORY_SCOPE_AGENT); }
__device__ __forceinline__ unsigned xb_xcc_id() { return (unsigned)__builtin_amdgcn_s_getreg((3 << 11) | 20) & 0xFu; }
#define XB_SPIN(cond, bar) do { unsigned _sp = 0; while (cond) { __builtin_amdgcn_s_sleep(1); \
    if ((++_sp & 255u) == 0u) { if (xb_ld(&(bar)[XB_TMO])) break; if (_sp > XB_SPIN_CAP) { atomicAdd(&(bar)[XB_TMO], 1u); break; } } } } while (0)
struct XcdBarrier { unsigned* bar; unsigned x; volatile LAS unsigned* st; };
__device__ __forceinline__ XcdBarrier xcd_barrier_post(unsigned* bar, volatile LAS unsigned* st, bool leader) {
    XcdBarrier b; b.bar = bar; b.x = xb_xcc_id(); b.st = st;
    if (leader) st[2] = xb_add(&bar[XB_XCNT(b.x)], 1u);
    return b;
}
__device__ __forceinline__ void xcd_barrier_complete(unsigned* bar, unsigned x, unsigned& nloc, unsigned& nx) {
    const unsigned G = gridDim.x * gridDim.y * gridDim.z;
    unsigned sum, cnt, mine, sp = 0u;
    for (;;) {
        sum = 0u; cnt = 0u; mine = 0u;
#pragma unroll
        for (unsigned j = 0; j < 16; ++j) { const unsigned c = xb_ld(&bar[XB_XCNT(j)]); sum += c; cnt += (c > 0u) ? 1u : 0u; mine = (j == x) ? c : mine; }
        if (sum == G) break;
        __builtin_amdgcn_s_sleep(1);
        if ((++sp & 255u) == 0u) { if (xb_ld(&bar[XB_TMO])) break; if (sp > XB_SPIN_CAP) { atomicAdd(&bar[XB_TMO], 1u); break; } }
    }
    nloc = mine > 0u ? mine : 1u; nx = cnt > 0u ? cnt : 1u;
}
__device__ __forceinline__ void xcd_barrier(const XcdBarrier& b, bool leader) {
    asm volatile("s_waitcnt vmcnt(0)" ::: "memory");
    __syncthreads();
    if (leader) {
        unsigned* bar = b.bar;
        __builtin_amdgcn_s_waitcnt(0);
        unsigned nloc = b.st[0], nx = b.st[1];
        if (nloc == 0u) { xcd_barrier_complete(bar, b.x, nloc, nx); b.st[0] = nloc; b.st[1] = nx; }
        const unsigned old = xb_add(&bar[XB_XSUB(b.x)], 1u);
        const unsigned gen = old / nloc;
        if (old + 1u == (gen + 1u) * nloc) {
            __builtin_amdgcn_fence(__ATOMIC_RELEASE, "agent");
            asm volatile("s_waitcnt vmcnt(0)" ::: "memory");
            const unsigned og = xb_add(&bar[XB_TOP], 1u);
            const unsigned tg = og / nx;
            if (og + 1u == (tg + 1u) * nx) xb_add(&bar[XB_TOPGEN], 1u);
            else XB_SPIN(xb_ld(&bar[XB_TOPGEN]) == tg, bar);
            __builtin_amdgcn_fence(__ATOMIC_ACQUIRE, "agent");
            xb_add(&bar[XB_XGEN(b.x)], 1u);
            asm volatile("s_waitcnt vmcnt(0)" ::: "memory");
        } else {
            XB_SPIN(xb_ld(&bar[XB_XGEN(b.x)]) == gen, bar);
            __builtin_amdgcn_fence(__ATOMIC_ACQUIRE, "agent");
            asm volatile("s_waitcnt vmcnt(0)" ::: "memory");
        }
    }
    __syncthreads();
}

struct Args { const float* in[23]; float* out; unsigned char* ws; int ph_lo, ph_hi; };
enum { I_X = 0, I_C, I_MIXG, I_WADA, I_BADA, I_WIN, I_LNG, I_LNB, I_GWS, I_GBS, I_POOLW, I_POOLS, I_GOUTG, I_POUTG, I_WOUT, I_FFNG, I_RW, I_RB, I_W1, I_B1, I_W2, I_B2, I_FING };

typedef __attribute__((address_space(4))) const Args* KArgs;
__device__ __forceinline__ KArgs kargs() { KArgs p = (KArgs)__builtin_amdgcn_kernarg_segment_ptr(); asm volatile("" : "+s"(p)); return p; }
namespace pg8 {
constexpr int BM = 256, BK = 64, HALF = 128, HTB = HALF * BK * 2, STAGE_BYTES = 8 * HTB, NXCD = 8, WGM = 8;
constexpr int K = 2048, NT = K / BK;
__host__ __device__ __forceinline__ int lds_byte(int r, int c) { const int st = (r >> 4) * 2 + (c >> 5), rr = r & 15, cc = c & 31, ob = rr * 64 + cc * 2; return st * 1024 + (ob ^ (((ob >> 9) & 1) << 5)); }
__host__ __device__ __forceinline__ void stage_rc(int b, int& R, int& C) { const int st = b / 1024, sb = b % 1024, swz = sb ^ (((sb >> 9) & 1) << 5); R = (st >> 1) * 16 + swz / 64; C = (st & 1) * 32 + (swz % 64) / 2; }
__host__ __device__ __forceinline__ int lds_byte8(int r, int cb) { const int st = (r >> 4) * 2 + (cb >> 6), rr = r & 15, ob = rr * 64 + (cb & 63); return st * 1024 + (ob ^ (((ob >> 9) & 1) << 4)); }
__host__ __device__ __forceinline__ void stage_rc8(int b, int& R, int& Cb) { const int st = b / 1024, sb = b % 1024, swz = sb ^ (((sb >> 9) & 1) << 4); R = (st >> 1) * 16 + swz / 64; Cb = (st & 1) * 64 + (swz % 64); }
typedef int v4i __attribute__((ext_vector_type(4)));
typedef int v8i __attribute__((ext_vector_type(8)));
__device__ __forceinline__ unsigned pk_fp8x4(float a, float b, float c, float d) { int w = 0; w = __builtin_amdgcn_cvt_pk_fp8_f32(a, b, w, false); w = __builtin_amdgcn_cvt_pk_fp8_f32(c, d, w, true); return (unsigned)w; }
constexpr float Y8_SCALE = 8.0f, Y8_INV = 1.0f / 8.0f;
constexpr float W8_SCALE = 256.0f, W8_INV = 1.0f / 256.0f;
__host__ __device__ __forceinline__ int perm32(int rho) { const int n = rho >> 4, i = rho & 15; return 8 * (i >> 2) + 4 * n + (i & 3); }

struct Unit { int pm, pn, e, ml; };

__device__ __forceinline__ bool order_next(int i, int G, int c, int nM, int nN, Unit& u) {
    const int nwg = nM * nN; const int L = i * G + c; if (L >= nwg) return false;
    int wgid = L; { const int q = nwg / NXCD, r = nwg % NXCD, xcd = wgid % NXCD, off = wgid / NXCD; wgid = (xcd < r ? xcd * (q + 1) : r * (q + 1) + (xcd - r) * q) + off; }
    const int nig = WGM * nN, gid = wgid / nig, fm = gid * WGM, gsz = (nM - fm) < WGM ? (nM - fm) : WGM;
    u.pm = fm + ((wgid % nig) % gsz); u.pn = (wgid % nig) / gsz; u.e = 0; u.ml = 0; return true;
}
template <int ROWB, size_t WS_A, size_t WS_B, int NM, int NN, bool ROWFAC = false> struct DenseSched {
    int G, c;
    __device__ __forceinline__ bool next(int i, Unit& u) const { return order_next(i, G, c, NM, NN, u); }
    __device__ __forceinline__ const char* a_base() const { return (const char*)(kargs()->ws + WS_A); }
    __device__ __forceinline__ const char* b_ptr(const Unit& u) const { return (const char*)(kargs()->ws + WS_B) + (size_t)u.pn * (256 * ROWB); }
    __device__ __forceinline__ bool need_prep(const Unit&, const Unit&) const { return false; }
    __device__ __forceinline__ void prep(const Unit&, int, int) const {}
    __device__ __forceinline__ void tables(const Unit& u, int eslot, int wid, int lane) const {
        if (ROWFAC) { if (wid < 2) { const char* src = (const char*)(kargs()->ws + (wid == 0 ? WS_RA : WS_RB)) + (size_t)u.pm * 1024 + 16 * lane;
                __builtin_amdgcn_global_load_lds((const unsigned*)src, (LAS unsigned*)(size_t)(TBL_OFF + eslot * 3072 + 1024 * wid), 16, 0, 0); } }
    }
    __device__ __forceinline__ void a_off(const Unit& u, int, const int (&Ri)[2], const int (&Ci2)[2], unsigned (&o)[2][2]) const {
#pragma unroll
        for (int h = 0; h < 2; ++h)
#pragma unroll
            for (int i = 0; i < 2; ++i) o[h][i] = (unsigned)(u.pm * 256 + h * 128 + Ri[i]) * (unsigned)ROWB + (unsigned)Ci2[i];
    }
};
template <bool GATHER, int ROWB, size_t WS_A, size_t WS_B, size_t BSTRIDE, int NN> struct MoeSched {
    int nM, G, c;
    __device__ __forceinline__ static const LAS int* tstart() { return (const LAS int*)(size_t)MOE_OFF; }
    __device__ __forceinline__ static const LAS int* ecnt() { return (const LAS int*)(size_t)(MOE_OFF + 160); }
    __device__ __forceinline__ static LAS unsigned* rowtab() { return (LAS unsigned*)(size_t)ROWTAB_OFF; }
    __device__ __forceinline__ bool next(int i, Unit& u) const {
        if (!order_next(i, G, c, nM, NN, u)) return false;
        int e = 0;
#pragma unroll
        for (int k = 1; k < NE; ++k) e += (tstart()[k] <= u.pm) ? 1 : 0;
        e = __builtin_amdgcn_readfirstlane(e);
        u.e = e; u.ml = u.pm - __builtin_amdgcn_readfirstlane(tstart()[e]); return true;
    }
    __device__ __forceinline__ const char* a_base() const { return (const char*)(kargs()->ws + WS_A); }
    __device__ __forceinline__ const char* b_ptr(const Unit& u) const { return (const char*)(kargs()->ws + WS_B) + (size_t)u.e * BSTRIDE + (size_t)u.pn * (256 * ROWB); }
    __device__ __forceinline__ bool need_prep(const Unit& a, const Unit& b) const { return GATHER && (a.pm != b.pm); }
    __device__ __forceinline__ void prep(const Unit& u, int slot, int tid) const {
        if (GATHER) {
            if (tid < 256) { const int* list = (const int*)(kargs()->ws + WS_LIST); const int a = 256 * u.ml + tid; const int n = ecnt()[u.e]; int ent = 0; if (a < n) ent = list[(size_t)u.e * LCAP + a];
                rowtab()[slot * 256 + tid] = (unsigned)(ent >> 2) * (unsigned)ROWB; } }
    }
    __device__ __forceinline__ void tables(const Unit& u, int eslot, int wid, int lane) const {
        KArgs ap = kargs(); LAS unsigned char* tb = (LAS unsigned char*)(size_t)(TBL_OFF + eslot * 3072);
        if (GATHER) { if (wid == 0) { const float* src = ap->in[I_B1] + (size_t)u.e * 4096 + (lane < 32 ? 128 * u.pn + 4 * lane : 2048 + 128 * u.pn + 4 * (lane - 32));
                __builtin_amdgcn_global_load_lds((const unsigned*)src, (LAS unsigned*)tb, 16, 0, 0); } }
        else { if (wid < 3) { const char* src = wid == 0 ? (const char*)(ap->in[I_B2] + (size_t)u.e * D + 256 * u.pn) : (const char*)(ap->ws + (wid == 1 ? WS_LIST : WS_LGATE)) + ((size_t)u.e * LCAP + 256 * u.ml) * 4;
                __builtin_amdgcn_global_load_lds((const unsigned*)(src + 16 * lane), (LAS unsigned*)(tb + 1024 * wid), 16, 0, 0); } }
    }
    __device__ __forceinline__ void a_off(const Unit& u, int slot, const int (&Ri)[2], const int (&Ci2)[2], unsigned (&o)[2][2]) const {
#pragma unroll
        for (int h = 0; h < 2; ++h)
#pragma unroll
            for (int i = 0; i < 2; ++i) {
                if (GATHER) o[h][i] = rowtab()[slot * 256 + h * 128 + Ri[i]] + (unsigned)Ci2[i];
                else o[h][i] = (unsigned)(u.pm * 256 + h * 128 + Ri[i]) * (unsigned)ROWB + (unsigned)Ci2[i];
            }
    }
};

__device__ __forceinline__ f32x2 gelu_pk(f32x2 v) {
    const f32x2 av = __builtin_elementwise_abs(v), d = av * 0.2316418882f + 1.0f;
    f32x2 t; t.x = __builtin_amdgcn_rcpf(d.x); t.y = __builtin_amdgcn_rcpf(d.y);
    f32x2 q = t * 0.5307027145f + (-0.7265760135f); q = q * t + 0.7107068705f; q = q * t + (-0.142248368f); q = q * t + 0.127414796f; q = q * t;
    const f32x2 s = (v * v) * (-0.72134752044f);
    f32x2 e; e.x = __builtin_amdgcn_exp2f(s.x); e.y = __builtin_amdgcn_exp2f(s.y);
    const f32x2 m = v * (q * e), r = v - m;
    f32x2 o; o.x = v.x < 0.f ? m.x : r.x; o.y = v.y < 0.f ? m.y : r.y; return o;
}

struct EpiZ {
    static constexpr bool PERM = true, HAS_MID = false;
    __device__ __forceinline__ void operator()(const f32x4 (&acc)[2][2][4][2], const Unit& u, int wr, int wc, int fr, int fq, int eslot) const {
        bf16* Z = (bf16*)(kargs()->ws + WS_Z);
        const int row0 = u.pm * BM + wr * 64 + fr, col0 = u.pn * BM + wc * 64 + 16 * fq; const bool act = u.pn < 8;
#pragma unroll
        for (int ai = 0; ai < 2; ++ai)
#pragma unroll
            for (int m = 0; m < 4; ++m) { bf16* rowp = Z + (size_t)(row0 + ai * HALF + m * 16) * ZW + col0;
#pragma unroll
                for (int bj = 0; bj < 2; ++bj) { f32x4 v0 = acc[ai][bj][m][0], v1 = acc[ai][bj][m][1];
                    if (act) { f32x2 a = gelu_pk((f32x2){v0[0], v0[1]}), b = gelu_pk((f32x2){v0[2], v0[3]}), c = gelu_pk((f32x2){v1[0], v1[1]}), d = gelu_pk((f32x2){v1[2], v1[3]});
                        v0 = (f32x4){a.x, a.y, b.x, b.y}; v1 = (f32x4){c.x, c.y, d.x, d.y}; }
                    v4u w; w.x = cvt_pk_bf16(v0[0], v0[1]); w.y = cvt_pk_bf16(v0[2], v0[3]); w.z = cvt_pk_bf16(v1[0], v1[1]); w.w = cvt_pk_bf16(v1[2], v1[3]);
                    *(v4u*)(rowp + bj * 8) = w; } }
    }
};
struct EpiRes {
    static constexpr bool PERM = true, HAS_MID = true;
    __device__ __forceinline__ void mid(f32x4 (&acc)[2][2][4][2], int wr, int fr, int eslot) const {
        const LAS float* ra = (const LAS float*)(size_t)(TBL_OFF + eslot * 3072); const LAS float* rb = ra + 256;
#pragma unroll
        for (int ai = 0; ai < 2; ++ai)
#pragma unroll
            for (int m = 0; m < 4; ++m) { const int r = ai * HALF + wr * 64 + m * 16 + fr; const float f = ra[r] * __builtin_amdgcn_rcpf(rb[r]);
#pragma unroll
                for (int bj = 0; bj < 2; ++bj)
#pragma unroll
                    for (int n = 0; n < 2; ++n) acc[ai][bj][m][n] = acc[ai][bj][m][n] * f; }
    }
    __device__ __forceinline__ void operator()(const f32x4 (&acc)[2][2][4][2], const Unit& u, int wr, int wc, int fr, int fq, int eslot) const {
        KArgs ap = kargs(); const float* x = ap->in[I_X]; bf16* x1 = (bf16*)(ap->ws + WS_X1); const float* mod = (const float*)(ap->ws + WS_MOD);
        const int row0 = u.pm * BM + wr * 64 + fr, col0 = u.pn * BM + wc * 64 + 16 * fq; const int b = (u.pm * BM) >= SEQ ? 1 : 0;
        f32x4 gm[2][2];
#pragma unroll
        for (int bj = 0; bj < 2; ++bj)
#pragma unroll
            for (int n = 0; n < 2; ++n) gm[bj][n] = *(const f32x4*)(mod + b * 12288 + 2 * D + col0 + bj * 8 + 4 * n);
#pragma unroll
        for (int ai = 0; ai < 2; ++ai) {
            f32x4 xs[4][2][2];
#pragma unroll
            for (int m = 0; m < 4; ++m)
#pragma unroll
                for (int bj = 0; bj < 2; ++bj) { const float* xp = x + (size_t)(row0 + ai * HALF + m * 16) * D + col0 + bj * 8; xs[m][bj][0] = *(const f32x4*)xp; xs[m][bj][1] = *(const f32x4*)(xp + 4); }
            asm volatile("" ::: "memory");
#pragma unroll
            for (int m = 0; m < 4; ++m) { const size_t off = (size_t)(row0 + ai * HALF + m * 16) * D + col0; const float rbv = ((const LAS float*)(size_t)(TBL_OFF + eslot * 3072 + 1024))[ai * HALF + wr * 64 + m * 16 + fr];
#pragma unroll
                for (int bj = 0; bj < 2; ++bj) {
                    const f32x4 o0 = xs[m][bj][0] + gm[bj][0] * (acc[ai][bj][m][0] * rbv), o1 = xs[m][bj][1] + gm[bj][1] * (acc[ai][bj][m][1] * rbv);
                    v4u w; w.x = cvt_pk_bf16(o0[0], o0[1]); w.y = cvt_pk_bf16(o0[2], o0[3]); w.z = cvt_pk_bf16(o1[0], o1[1]); w.w = cvt_pk_bf16(o1[2], o1[3]);
                    *(v4u*)(x1 + off + bj * 8) = w; }
                __builtin_amdgcn_sched_barrier(0); }
            asm volatile("" ::: "memory");
        }
    }
};
struct EpiSwiglu {
    static constexpr bool PERM = true, HAS_MID = false, HALVES = true;
    template <int AI> __device__ __forceinline__ void half(const f32x4 (&acc)[2][2][4][2], const Unit& u, int wr, int wc, int fr, int fq, int eslot) const {
        KArgs ap = kargs(); unsigned char* ACT = ap->ws + WS_ACT;
        const LAS float* btab = (const LAS float*)(size_t)(TBL_OFF + eslot * 3072) + wc * 32 + 8 * fq;
        const int row0 = u.pm * BM + wr * 64 + fr, colj = u.pn * HALF + wc * 32 + 8 * fq;
        constexpr int ai = AI;
#pragma unroll
            for (int m = 0; m < 4; ++m) { unsigned char* rowp = ACT + (size_t)(row0 + ai * HALF + m * 16) * D + colj; unsigned ow[2];
#pragma unroll
                for (int n = 0; n < 2; ++n) { const f32x4 g4 = acc[ai][0][m][n] * W8_INV + *(const LAS f32x4*)(btab + 4 * n), l4 = acc[ai][1][m][n] * W8_INV + *(const LAS f32x4*)(btab + 128 + 4 * n); float o[4];
#pragma unroll
                    for (int j = 0; j < 4; ++j) { const float g = fminf(g4[j], 7.0f), l = fminf(fmaxf(l4[j], -7.0f), 7.0f);
                        const float sg = __builtin_amdgcn_rcpf(1.0f + __builtin_amdgcn_exp2f(-2.45546696f * g)); o[j] = g * sg * (l + 1.0f); }
                    ow[n] = pk_fp8x4(o[0], o[1], o[2], o[3]); }
                v2u w; w.x = ow[0]; w.y = ow[1];
                *(v2u*)rowp = w; }
    }
    __device__ __forceinline__ void operator()(const f32x4 (&acc)[2][2][4][2], const Unit& u, int wr, int wc, int fr, int fq, int eslot) const {
        half<0>(acc, u, wr, wc, fr, fq, eslot); half<1>(acc, u, wr, wc, fr, fq, eslot);
    }
};
struct EpiY {
    static constexpr bool PERM = true, HAS_MID = false;
    __device__ __forceinline__ void operator()(const f32x4 (&acc)[2][2][4][2], const Unit& u, int wr, int wc, int fr, int fq, int eslot) const {
        KArgs ap = kargs(); unsigned char* Y4 = ap->ws + WS_Y4;
        const LAS float* btab = (const LAS float*)(size_t)(TBL_OFF + eslot * 3072) + wc * 64 + 16 * fq;
        const LAS int* etab = (const LAS int*)(size_t)(TBL_OFF + eslot * 3072 + 1024); const LAS float* gtab = (const LAS float*)(size_t)(TBL_OFF + eslot * 3072 + 2048);
        const int col0 = u.pn * BM + wc * 64 + 16 * fq; const int n_e = ((const LAS int*)(size_t)(MOE_OFF + 160))[u.e];
#pragma unroll
        for (int ai = 0; ai < 2; ++ai)
#pragma unroll
            for (int m = 0; m < 4; ++m) { const int r = ai * HALF + wr * 64 + m * 16 + fr;
                if (256 * u.ml + r < n_e) { const int ent = etab[r]; const float gt = gtab[r] * Y8_SCALE; unsigned char* rowp = Y4 + (size_t)ent * D + col0;
                    v4u w;
#pragma unroll
                    for (int bj = 0; bj < 2; ++bj) { const f32x4 b0 = *(const LAS f32x4*)(btab + bj * 8), b1 = *(const LAS f32x4*)(btab + bj * 8 + 4);
                        const f32x4 v0 = (acc[ai][bj][m][0] * W8_INV + b0) * gt, v1 = (acc[ai][bj][m][1] * W8_INV + b1) * gt;
                        w[2 * bj] = pk_fp8x4(v0[0], v0[1], v0[2], v0[3]); w[2 * bj + 1] = pk_fp8x4(v1[0], v1[1], v1[2], v1[3]); }
                    *(v4u*)rowp = w; } }
    }
};

struct AuxNone { static constexpr bool ON = false; static constexpr int NSL = 0;
    __device__ __forceinline__ void issue(f32x4 (&)[8], int, int, int) const {} __device__ __forceinline__ void consume(const f32x4 (&)[8], int, int, int) const {} };
struct AuxW2 { static constexpr bool ON = true; static constexpr int NSL = 32; int gw;
    __device__ __forceinline__ static void coords(int sid, int lane, int& e, int& k0, int& n0) { const int nb = sid & 63, kb = (sid >> 6) & 31; e = sid >> 11; k0 = 64 * kb + 8 * (lane >> 3); n0 = 32 * nb + 4 * (lane & 7); }
    __device__ __forceinline__ void issue(f32x4 (&v)[8], int j, int, int lane) const { int e, k0, n0; coords(gw + 2048 * j, lane, e, k0, n0);
        const float* sp = kargs()->in[I_W2] + (size_t)e * D * D + (unsigned)(k0 * D + n0);
#pragma unroll
        for (int r = 0; r < 8; ++r) v[r] = *(const f32x4*)(sp + r * D); }
    __device__ __forceinline__ void consume(const f32x4 (&v)[8], int j, int, int lane) const { int e, k0, n0; coords(gw + 2048 * j, lane, e, k0, n0);
        unsigned char* dp = kargs()->ws + WS_W2T + (size_t)e * D * D + (unsigned)(n0 * D + k0);
#pragma unroll
        for (int c = 0; c < 4; ++c) { v2u o; o.x = pk_fp8x4(v[0][c] * W8_SCALE, v[1][c] * W8_SCALE, v[2][c] * W8_SCALE, v[3][c] * W8_SCALE); o.y = pk_fp8x4(v[4][c] * W8_SCALE, v[5][c] * W8_SCALE, v[6][c] * W8_SCALE, v[7][c] * W8_SCALE);
            *(v2u*)(dp + c * D) = o; } }
};
template <int E0, int NSL_> struct AuxW1 { static constexpr bool ON = true; static constexpr int NSL = NSL_; int gw;
    __device__ __forceinline__ void issue(f32x4 (&v)[8], int j, int, int lane) const { const int sid = gw * NSL_ + j, kb = (sid >> 7) & 31, nb = sid & 127, e = E0 + (sid >> 12);
        const float* sp = kargs()->in[I_W1] + (size_t)e * D * 4096 + (unsigned)((64 * kb + 8 * (lane >> 3)) * 4096 + 32 * nb + 4 * (lane & 7));
#pragma unroll
        for (int r = 0; r < 8; ++r) v[r] = *(const f32x4*)(sp + r * 4096); }
    __device__ __forceinline__ void consume(const f32x4 (&v)[8], int j, int, int lane) const { const int sid = gw * NSL_ + j, kb = (sid >> 7) & 31, nb = sid & 127, e = E0 + (sid >> 12);
        const int n0 = 32 * nb, hf = n0 >> 11, j0 = n0 & 2047, n0p = 256 * (j0 >> 7) + 16 * ((j0 & 127) >> 3) + 8 * hf, nq = lane & 7;
        unsigned char* dp = kargs()->ws + WS_W1T + ((size_t)e * 4096 + n0p + 16 * (nq >> 1) + 4 * (nq & 1)) * D + 64 * kb + 8 * (lane >> 3);
#pragma unroll
        for (int c = 0; c < 4; ++c) { v2u o; o.x = pk_fp8x4(v[0][c] * W8_SCALE, v[1][c] * W8_SCALE, v[2][c] * W8_SCALE, v[3][c] * W8_SCALE); o.y = pk_fp8x4(v[4][c] * W8_SCALE, v[5][c] * W8_SCALE, v[6][c] * W8_SCALE, v[7][c] * W8_SCALE);
            *(v2u*)(dp + (size_t)c * D) = o; } }
};

template <class Epi, class Sched, bool ALIGN_EPI, bool SP2, bool FP8, class Aux = AuxNone>
__device__ __forceinline__ int gemm_phase(LAS unsigned char* lds, const Sched& S, const Epi& E, int wave_, const Aux& X = Aux()) {
    const int wid = wave_, lane = lane_id(), tid = wid * 64 + lane, wr = wid >> 2, wc = wid & 3, fr = lane & 15, fq = lane >> 4;
    constexpr int nt = FP8 ? NT / 2 : NT;
    constexpr int ROWB = FP8 ? K : K * 2;
    unsigned voffB[2];
#pragma unroll
    for (int i = 0; i < 2; ++i) { int R, C; if constexpr (FP8) stage_rc8(tid * 16 + i * 8192, R, C); else { stage_rc(tid * 16 + i * 8192, R, C); C *= 2; }
        int Rb = R; if (Epi::PERM) { const int sp = (R & ~31) + perm32(R & 31); Rb = 16 * (sp >> 3) + (sp & 7); }
        voffB[i] = (unsigned)(Rb * ROWB + C); }
#define PG8_AOFF(unit, slot_, dst) do { const int tl_ = wid * 64 + lane_id(); int Ri_[2], Ci_[2]; _Pragma("unroll") for (int i_ = 0; i_ < 2; ++i_) { int R_, C_; \
        if constexpr (FP8) stage_rc8(tl_ * 16 + i_ * 8192, R_, C_); else { stage_rc(tl_ * 16 + i_ * 8192, R_, C_); C_ *= 2; } Ri_[i_] = R_; Ci_[i_] = C_; } S.a_off(unit, slot_, Ri_, Ci_, dst); } while (0)
    const size_t kstep = (size_t)(BK * 2);
    const size_t hstep = Epi::PERM ? (size_t)8 * ROWB : (size_t)HALF * ROWB;
    const unsigned ldsw = (unsigned)wid * 1024u;
    const int aoff = FP8 ? lds_byte8(wr * 64 + fr, fq * 32) : lds_byte(wr * 64 + fr, fq * 8), boff = FP8 ? lds_byte8(wc * 32 + fr, fq * 32) : lds_byte(wc * 32 + fr, fq * 8);
    const int aof2 = FP8 ? lds_byte8(wr * 64 + fr, fq * 32 + 16) : aoff + 1024, bof2 = FP8 ? lds_byte8(wc * 32 + fr, fq * 32 + 16) : boff + 1024;
#define PG8_SA(b, h) (((b) * 2 + (h)) * HTB)
#define PG8_SB(b, h) ((4 + (b) * 2 + (h)) * HTB)
#define PG8_STAGE(bufoff, gbase, voff) do { _Pragma("unroll") for (int _i = 0; _i < 2; ++_i) { asm volatile("" : "+v"((voff)[_i])); const unsigned vo_ = (voff)[_i];     \
        __builtin_amdgcn_global_load_lds((const unsigned*)((const char*)(gbase) + vo_), (LAS unsigned*)(lds + (bufoff) + ldsw + _i * 8192), 16, 0, 0); } } while (0)
#define PG8_LDA(dst, b, h) do { _Pragma("unroll") for (int m = 0; m < 4; ++m) { dst[m][0] = *(const LAS bf16x8*)(lds + PG8_SA(b, h) + aoff + m * 2048); dst[m][1] = *(const LAS bf16x8*)(lds + PG8_SA(b, h) + aof2 + m * 2048); } } while (0)
#define PG8_LDB(dst, b, h) do { _Pragma("unroll") for (int n = 0; n < 2; ++n) { dst[n][0] = *(const LAS bf16x8*)(lds + PG8_SB(b, h) + boff + n * 2048); dst[n][1] = *(const LAS bf16x8*)(lds + PG8_SB(b, h) + bof2 + n * 2048); } } while (0)
#define PG8_MMA(ai, bj, At, Bt) do { __builtin_amdgcn_s_setprio(1); _Pragma("unroll") for (int m = 0; m < 4; ++m) _Pragma("unroll") for (int n = 0; n < 2; ++n) { \
        if constexpr (FP8) { const v4i b0_ = __builtin_bit_cast(v4i, Bt[n][0]), b1_ = __builtin_bit_cast(v4i, Bt[n][1]), a0_ = __builtin_bit_cast(v4i, At[m][0]), a1_ = __builtin_bit_cast(v4i, At[m][1]); \
            acc[ai][bj][m][n] = __builtin_amdgcn_mfma_scale_f32_16x16x128_f8f6f4(__builtin_shufflevector(b0_, b1_, 0, 1, 2, 3, 4, 5, 6, 7), __builtin_shufflevector(a0_, a1_, 0, 1, 2, 3, 4, 5, 6, 7), acc[ai][bj][m][n], 0, 0, 0, 0x7f7f7f7f, 0, 0x7f7f7f7f); } \
        else { _Pragma("unroll") for (int k = 0; k < 2; ++k) acc[ai][bj][m][n] = __builtin_amdgcn_mfma_f32_16x16x32_bf16(Bt[n][k], At[m][k], acc[ai][bj][m][n], 0, 0, 0); } } \
        __builtin_amdgcn_s_setprio(0); } while (0)
#define PG8_WAIT_V(n) asm volatile("s_waitcnt vmcnt(" #n ")" ::: "memory")
#define PG8_WAIT_L(n) asm volatile("s_waitcnt lgkmcnt(" #n ")" ::: "memory")
#define PG8_BAR __builtin_amdgcn_s_barrier()
#define PG8_SCHED __builtin_amdgcn_sched_barrier(0)
    Unit cur, nxt; int ui = 0;
    if (!S.next(0, cur)) return 0;
    f32x4 acc[2][2][4][2];
#pragma unroll
    for (int a = 0; a < 2; ++a)
#pragma unroll
        for (int b = 0; b < 2; ++b)
#pragma unroll
            for (int m = 0; m < 4; ++m)
#pragma unroll
                for (int n = 0; n < 2; ++n) acc[a][b][m][n] = (f32x4){0.f, 0.f, 0.f, 0.f};
    bf16x8 At[4][2], B0[2][2], B1[2][2];
    const char* const Ab = S.a_base();
    const char* cB = S.b_ptr(cur);
    int slot = 0;
    S.tables(cur, 0, wid, lane);
    S.prep(cur, slot, tid); PG8_WAIT_L(0); PG8_BAR; asm volatile("" ::: "memory");
    unsigned ao[2][2];
    PG8_AOFF(cur, slot, ao);
    if constexpr (SP2) {
        PG8_STAGE(PG8_SB(0, 0), cB, voffB); PG8_STAGE(PG8_SB(0, 1), cB + hstep, voffB); PG8_STAGE(PG8_SA(0, 0), Ab, ao[0]); PG8_STAGE(PG8_SA(0, 1), Ab, ao[1]);
        if (wr == 1) PG8_BAR;
        PG8_WAIT_V(2); PG8_BAR;
        PG8_STAGE(PG8_SB(1, 0), cB + kstep, voffB); PG8_STAGE(PG8_SA(1, 0), Ab + kstep, ao[0]); PG8_STAGE(PG8_SB(1, 1), cB + hstep + kstep, voffB);
        PG8_WAIT_V(6); PG8_BAR;
    } else {
        PG8_STAGE(PG8_SB(0, 0), cB, voffB); PG8_STAGE(PG8_SA(0, 0), Ab, ao[0]); PG8_STAGE(PG8_SB(0, 1), cB + hstep, voffB); PG8_STAGE(PG8_SA(0, 1), Ab, ao[1]);
        if (wr == 1) PG8_BAR;
        PG8_WAIT_V(4); PG8_BAR;
        PG8_STAGE(PG8_SB(1, 0), cB + kstep, voffB); PG8_STAGE(PG8_SA(1, 0), Ab + kstep, ao[0]); PG8_STAGE(PG8_SB(1, 1), cB + hstep + kstep, voffB);
        PG8_WAIT_V(6); PG8_BAR;
    }
    for (;;) {
        const bool has_next = S.next(ui + 1, nxt);
        const char* nB = has_next ? S.b_ptr(nxt) : cB;
        if (ui > 0) S.tables(cur, ui & 1, wid, lane_id());
        if (has_next && S.need_prep(cur, nxt)) { slot ^= 1; S.prep(nxt, slot, wid * 64 + lane_id()); }
        for (int t = 0; t < nt; t += 2) {
            const bool last = (t == nt - 2);
            const char* a1 = Ab + (size_t)(t + 1) * kstep;
            const char* a2 = last ? Ab : Ab + (size_t)(t + 2) * kstep; const char* b2 = last ? nB : cB + (size_t)(t + 2) * kstep;
            const char* a3 = a2 + kstep; const char* b3 = b2 + kstep;
            if constexpr (SP2) {
            static_assert(SP2, "only the two-super-phase loop is kept");
            if constexpr (Epi::HAS_MID) { if (t == nt / 2) E.mid(acc, wr, lane_id() & 15, ui & 1); }
            unsigned ao1c[2] = {ao[1][0], ao[1][1]};
            if (last && has_next) PG8_AOFF(nxt, slot, ao);
            PG8_LDB(B0, 0, 0); PG8_LDB(B1, 0, 1); PG8_SCHED; PG8_LDA(At, 0, 0); PG8_STAGE(PG8_SA(1, 1), a1, ao1c);
            PG8_WAIT_V(8); PG8_WAIT_L(0); PG8_BAR; PG8_MMA(0, 0, At, B0); PG8_MMA(0, 1, At, B1); PG8_BAR; PG8_SCHED;
            PG8_LDA(At, 0, 1); PG8_STAGE(PG8_SB(0, 0), b2, voffB); PG8_STAGE(PG8_SB(0, 1), b2 + hstep, voffB); PG8_STAGE(PG8_SA(0, 0), a2, ao[0]);
            PG8_WAIT_V(8); PG8_WAIT_L(0); PG8_BAR; PG8_MMA(1, 0, At, B0); PG8_MMA(1, 1, At, B1); PG8_BAR; PG8_SCHED;
            PG8_LDB(B0, 1, 0); PG8_LDB(B1, 1, 1); PG8_SCHED; PG8_LDA(At, 1, 0); PG8_STAGE(PG8_SA(0, 1), a2, ao[1]);
            PG8_WAIT_V(8); PG8_WAIT_L(0); PG8_BAR; PG8_MMA(0, 0, At, B0); PG8_MMA(0, 1, At, B1); PG8_BAR; PG8_SCHED;
            PG8_LDA(At, 1, 1); PG8_STAGE(PG8_SB(1, 0), b3, voffB); PG8_STAGE(PG8_SB(1, 1), b3 + hstep, voffB); PG8_STAGE(PG8_SA(1, 0), a3, ao[0]);
            PG8_WAIT_V(8); PG8_WAIT_L(0); PG8_BAR; PG8_MMA(1, 0, At, B0); PG8_MMA(1, 1, At, B1); PG8_BAR; PG8_SCHED;
            }
        }
        if constexpr (ALIGN_EPI) { if (wr == 0) PG8_BAR; }
        if constexpr (Aux::ON) {
            f32x4 xv_[8];
            asm volatile("" ::: "memory"); PG8_SCHED;
            X.issue(xv_, ui < Aux::NSL ? ui : Aux::NSL - 1, wid, lane_id());
            asm volatile("" ::: "memory"); PG8_SCHED;
            { const int ln_ = lane_id(); E(acc, cur, wr, wc, ln_ & 15, ln_ >> 4, ui & 1); }
            asm volatile("" ::: "memory"); PG8_SCHED;
            X.consume(xv_, ui < Aux::NSL ? ui : Aux::NSL - 1, wid, lane_id());
        } else
        { const int ln_ = lane_id(); E(acc, cur, wr, wc, ln_ & 15, ln_ >> 4, ui & 1); }
        if (!has_next) break;
#pragma unroll
        for (int a = 0; a < 2; ++a)
#pragma unroll
            for (int b = 0; b < 2; ++b)
#pragma unroll
                for (int m = 0; m < 4; ++m)
#pragma unroll
                    for (int n = 0; n < 2; ++n) acc[a][b][m][n] = (f32x4){0.f, 0.f, 0.f, 0.f};
        cur = nxt; cB = nB; ++ui;
        if constexpr (ALIGN_EPI) { if (wr == 1) PG8_BAR; }
    }
    PG8_WAIT_V(0);
    if constexpr (!ALIGN_EPI) { if (wr == 0) PG8_BAR; }
    PG8_BAR;
    return ui + 1;
#undef PG8_AOFF
#undef PG8_SA
#undef PG8_SB
#undef PG8_STAGE
#undef PG8_LDA
#undef PG8_LDB
#undef PG8_MMA
#undef PG8_WAIT_V
#undef PG8_WAIT_L
#undef PG8_BAR
#undef PG8_SCHED
}
}

struct Frame {
    LAS unsigned char* lds;
    unsigned char* ws;
    int tid, lane, wave, G, blk, vblk;
};

__device__ __forceinline__ void phase0(Frame& F, const float* c, const float* w_ada) {
    LAS float* cond = (LAS float*)(F.lds);
    LAS float* red = (LAS float*)(F.lds + 4096);
    float* modp = (float*)(F.ws + WS_MODP);
    for (int item = F.blk; item < 256; item += F.G) {
        const int rg = item & 3, cg = item >> 2;
        for (int i = F.tid; i < 1024; i += NTHR) { const int b = i >> 9, d = i & 511; const float v = c[b * D + 512 * rg + d]; cond[i] = v / (1.0f + __expf(-v)); }
        __syncthreads();
        const int c4 = F.tid % 48, rl = F.tid / 48;
        if (rl < 10) {
            f32x4 a0 = {0.f, 0.f, 0.f, 0.f}, a1 = {0.f, 0.f, 0.f, 0.f};
            const float* wp = w_ada + (size_t)(512 * rg) * 12288 + 192 * cg + 4 * c4;
#pragma unroll 13
            for (int d = rl; d < 512; d += 10) { const f32x4 w = *(const f32x4*)(wp + (size_t)d * 12288); a0 += w * cond[d]; a1 += w * cond[512 + d]; }
            *(LAS f32x4*)(red + (rl * 2 + 0) * 192 + 4 * c4) = a0; *(LAS f32x4*)(red + (rl * 2 + 1) * 192 + 4 * c4) = a1;
        }
        __syncthreads();
        if (F.tid < 384) { const int b = F.tid / 192, col = F.tid % 192; float s = 0.f;
#pragma unroll
            for (int r = 0; r < 10; ++r) s += red[(r * 2 + b) * 192 + col];
            modp[(rg * 2 + b) * 12288 + 192 * cg + col] = s; }
        __syncthreads();
    }
}

__device__ __forceinline__ void tr_item(const float* src, int ld_src, bf16* dst, int ld_dst, const float* kscale, LAS unsigned* scr, int lane) {
    const int kq = lane >> 4, nq = lane & 15;
#pragma unroll 4
    for (int i = 0; i < 16; ++i) { const int k = 8 * i + 2 * kq;
        f32x4 v0 = *(const f32x4*)(src + (size_t)k * ld_src + 4 * nq), v1 = *(const f32x4*)(src + (size_t)(k + 1) * ld_src + 4 * nq);
        if (kscale) { v0 = v0 * kscale[k]; v1 = v1 * kscale[k + 1]; }
#pragma unroll
        for (int j = 0; j < 4; ++j) { const int n = 4 * nq + j; scr[n * 64 + 4 * (i ^ nq) + kq] = cvt_pk_bf16(v0[j], v1[j]); } }
    LDS_WAIT(); asm volatile("" ::: "memory");
#pragma unroll 4
    for (int jj = 0; jj < 16; ++jj) { const int id = jj * 64 + lane, n = id >> 4, c = id & 15;
        const v4u o = *(const LAS v4u*)(scr + n * 64 + 4 * (c ^ ((n >> 2) & 15)));
        *(v4u*)(dst + (size_t)n * ld_dst + 8 * c) = o; }
    LDS_WAIT(); asm volatile("" ::: "memory");
}

template <bool ILV> __device__ __forceinline__ void tr_item8(const float* src, int ld_src, unsigned char* dst, int ld_dst, float scale, LAS unsigned* scr, int lane) {
    const int kq = lane >> 3, nq = lane & 7;
#pragma unroll 8
    for (int i = 0; i < 8; ++i) { const int k = 32 * i + 4 * kq; const float* sp = src + (size_t)k * ld_src + 4 * nq;
        const f32x4 v0 = *(const f32x4*)sp * scale, v1 = *(const f32x4*)(sp + ld_src) * scale, v2 = *(const f32x4*)(sp + 2 * (size_t)ld_src) * scale, v3 = *(const f32x4*)(sp + 3 * (size_t)ld_src) * scale;
#pragma unroll
        for (int j = 0; j < 4; ++j) scr[(4 * nq + j) * 65 + 8 * i + kq] = pg8::pk_fp8x4(v0[j], v1[j], v2[j], v3[j]); }
    LDS_WAIT(); asm volatile("" ::: "memory");
#pragma unroll 4
    for (int jj = 0; jj < 8; ++jj) { const int id = jj * 64 + lane, n = id >> 4, c = id & 15; const LAS unsigned* p = scr + n * 65 + 4 * c;
        v4u o; o.x = p[0]; o.y = p[1]; o.z = p[2]; o.w = p[3];
        *(v4u*)(dst + (size_t)(ILV ? 16 * (n >> 3) + (n & 7) : n) * ld_dst + 16 * c) = o; }
    LDS_WAIT(); asm volatile("" ::: "memory");
}

__device__ __forceinline__ void phase1(Frame& F) {
    KArgs Ap = kargs(); struct { const float* in[23]; } A;
#pragma unroll
    for (int i = 0; i < 23; ++i) A.in[i] = Ap->in[i];
    const float* modp = (const float*)(F.ws + WS_MODP); float* mod = (float*)(F.ws + WS_MOD);
    const float* b_ada = A.in[I_BADA];
    for (int item = F.blk; item < 256; item += F.G) {
        if (F.tid < 96) { const int j = 96 * item + F.tid, b = j / 12288, jj = j % 12288; float s = b_ada[jj];
#pragma unroll
            for (int rg = 0; rg < 4; ++rg) s += modp[(rg * 2 + b) * 12288 + jj];
            mod[j] = s; }
    }
    LAS float* gs = (LAS float*)(F.lds + TAB_OFF); LAS float* sh = gs + D;
    bf16* H = (bf16*)(F.ws + WS_H); const float* x = A.in[I_X]; const float* mixg = A.in[I_MIXG];
    for (int item = F.blk; item < 256; item += F.G) {
        const int b = item >> 7;
        __syncthreads();
        for (int d = F.tid; d < D; d += NTHR) { float sc = b_ada[D + d], sf = b_ada[d];
#pragma unroll
            for (int rg = 0; rg < 4; ++rg) { sc += modp[(rg * 2 + b) * 12288 + D + d]; sf += modp[(rg * 2 + b) * 12288 + d]; }
            gs[d] = mixg[d] * (1.0f + sc); sh[d] = sf; }
        __syncthreads();
        f32x4 vn[4][2];
        { const float* xr = x + (size_t)(128 * item + 16 * F.wave) * D + 8 * F.lane;
#pragma unroll
          for (int j = 0; j < 4; ++j) { vn[j][0] = *(const f32x4*)(xr + 512 * j); vn[j][1] = *(const f32x4*)(xr + 512 * j + 4); } }
#pragma unroll 1
        for (int r = 0; r < 16; ++r) { const int row = 128 * item + 16 * F.wave + r;
            f32x4 v[4][2]; float ss = 0.f;
#pragma unroll
            for (int j = 0; j < 4; ++j) { v[j][0] = vn[j][0]; v[j][1] = vn[j][1]; }
            if (r < 15) { const float* xr = x + (size_t)(row + 1) * D + 8 * F.lane;
#pragma unroll
                for (int j = 0; j < 4; ++j) { vn[j][0] = *(const f32x4*)(xr + 512 * j); vn[j][1] = *(const f32x4*)(xr + 512 * j + 4); } }
#pragma unroll
            for (int j = 0; j < 4; ++j) {
                ss += (v[j][0][0] * v[j][0][0] + v[j][0][1] * v[j][0][1]) + (v[j][0][2] * v[j][0][2] + v[j][0][3] * v[j][0][3]) + (v[j][1][0] * v[j][1][0] + v[j][1][1] * v[j][1][1]) + (v[j][1][2] * v[j][1][2] + v[j][1][3] * v[j][1][3]); }
            const float rstd = 1.0f / sqrtf(wave_sum(ss) * (1.0f / D) + RMS_EPS);
#pragma unroll
            for (int j = 0; j < 4; ++j) { const int col = 8 * F.lane + 512 * j;
                const f32x4 g0 = *(const LAS f32x4*)(gs + col), g1 = *(const LAS f32x4*)(gs + col + 4), s0 = *(const LAS f32x4*)(sh + col), s1 = *(const LAS f32x4*)(sh + col + 4);
                const f32x4 o0 = v[j][0] * rstd * g0 + s0, o1 = v[j][1] * rstd * g1 + s1;
                v4u w; w.x = cvt_pk_bf16(o0[0], o0[1]); w.y = cvt_pk_bf16(o0[2], o0[3]); w.z = cvt_pk_bf16(o1[0], o1[1]); w.w = cvt_pk_bf16(o1[2], o1[3]);
                *(v4u*)(H + (size_t)row * D + col) = w; } }
    }
    { const float* gws = A.in[I_GWS]; unsigned* wsb = (unsigned*)(F.ws + WS_WSB);
      for (int p = F.blk * NTHR + F.tid; p < 8 * 128 * 64; p += F.G * NTHR) { const int j = (p & 63) * 2, i = (p >> 6) & 127;
          const bool keep = (i >> 6) >= (j >> 6); const float a = keep ? gws[2 * p] : 0.f, b = keep ? gws[2 * p + 1] : 0.f; wsb[p] = cvt_pk_bf16(a, b); } }
    { const float* rw = A.in[I_RW]; float* rwp = (float*)(F.ws + WS_RWP);
      for (int p = F.blk * NTHR + F.tid; p < D * NE; p += F.G * NTHR) { const int k = p & 3, ln = (p >> 2) & 63, c = (p >> 8) & 3, eh = (p >> 10) & 1, sI = (p >> 11) & 3, wI = p >> 13;
          rwp[p] = rw[(256 * wI + 64 * sI + 16 * (ln >> 4) + 4 * c + k) * NE + 16 * eh + (ln & 15)]; } }
    LAS unsigned* scr = (LAS unsigned*)(F.lds + RING_OFF + F.wave * 16384);
    const int gw = F.blk * NWAVES + F.wave, NGW = F.G * NWAVES;
    constexpr int I_IN = 16 * 48, I_OUT = 16 * 32, I_PW = 4 * 2 * 4;
    for (int it = gw; it < I_IN + I_OUT + I_PW; it += NGW) {
        int r = it;
        if (r < I_IN) { const int kb = r / 48, nb = r % 48;
            tr_item(A.in[I_WIN] + (size_t)(128 * kb) * ZW + 64 * nb, ZW, (bf16*)(F.ws + WS_WIN) + (size_t)(64 * nb) * D + 128 * kb, D, nullptr, scr, F.lane); continue; }
        r -= I_IN;
        if (r < I_OUT) { const int kb = r >> 5, nb = r & 31; const float* ks = (kb < 8) ? (A.in[I_GOUTG] + 128 * kb) : (A.in[I_POUTG] + 128 * (kb - 8));
            tr_item(A.in[I_WOUT] + (size_t)(128 * kb) * D + 64 * nb, D, (bf16*)(F.ws + WS_WOUT) + (size_t)(64 * nb) * D + 128 * kb, D, ks, scr, F.lane); continue; }
        r -= I_OUT;
        { const int g = r >> 3, kb = (r >> 2) & 1, nb = r & 3;
          tr_item(A.in[I_POOLW] + (size_t)g * 65536 + (size_t)(128 * kb) * 256 + 64 * nb, 256, (bf16*)(F.ws + WS_PWT) + (size_t)g * 65536 + (size_t)(64 * nb) * 256 + 128 * kb, 256, nullptr, scr, F.lane); }
    }
}

#ifndef CV_EXTRA
#define CV_EXTRA 5120
#endif
__device__ __forceinline__ void convert_item(const float* w1, const float* w2, unsigned char* ws, int r, LAS unsigned* scr, int lane) {
    constexpr int I_1 = 32 * 16 * 64;
    if (r < I_1) { const int e = r >> 10, kb = (r >> 7) & 7, nb = r & 127; const int n0 = 32 * nb, half = n0 >> 11, j0 = n0 & 2047, n0p = 256 * (j0 >> 7) + 16 * ((j0 & 127) >> 3) + 8 * half;
        tr_item8<true>(w1 + (size_t)e * D * 4096 + (size_t)(256 * kb) * 4096 + n0, 4096, ws + WS_W1T + ((size_t)e * 4096 + n0p) * D + 256 * kb, D, pg8::W8_SCALE, scr, lane); return; }
    r -= I_1;
    { const int e = r >> 9, kb = (r >> 6) & 7, nb = r & 63;
        tr_item8<false>(w2 + (size_t)e * D * D + (size_t)(256 * kb) * D + 32 * nb, D, ws + WS_W2T + ((size_t)e * D + 32 * nb) * D + 256 * kb, D, pg8::W8_SCALE, scr, lane); }
}
__device__ __forceinline__ void convert_big(Frame& F, bool first) {
    KArgs Ap = kargs(); const float* w1 = Ap->in[I_W1]; const float* w2 = Ap->in[I_W2];
    LAS unsigned* scr = (LAS unsigned*)(F.lds + RING_OFF + F.wave * 16384);
    constexpr int N_ALL = 21 * 16 * 64, N_X = CV_EXTRA;
    if (first) { const int gt = (F.vblk >> 1) * NWAVES + F.wave, NGT = ((F.G + 1) >> 1) * NWAVES;
        for (int it = gt; it < N_X; it += NGT) convert_item(w1, w2, F.ws, it, scr, F.lane); }
    const int gw = F.vblk * NWAVES + F.wave, NGW = F.G * NWAVES;
    for (int it = N_X + gw; it < N_ALL; it += NGW) convert_item(w1, w2, F.ws, it, scr, F.lane);
}

__device__ __forceinline__ int vsw(int d) { return (d & 15) ^ ((d >> 4) & 7); }
__device__ __forceinline__ f32x4 bf4(v2u r) { return (f32x4){bf_lo(r.x), bf_hi(r.x), bf_lo(r.y), bf_hi(r.y)}; }
__device__ __forceinline__ void pool_stage(const bf16* Z, int t0, int tpos0, int g, int rq  , int c4  , LAS unsigned* poolA) {
    const int win = 2 << g;
    const bf16* zu = Z + (size_t)t0 * ZW + 2048 + 256 * g;
    v2u raw[32];
#pragma unroll
    for (int k = 0; k < 32; ++k) { const int t = 16 * rq - 16 + k; const int tc = (tpos0 + t >= 0) ? t : 0; raw[k] = *(const v2u*)(zu + (long)tc * ZW + 4 * c4); if (tpos0 + t < 0) raw[k] = (v2u){0u, 0u}; }
    f32x4 S = {0.f, 0.f, 0.f, 0.f};
#pragma unroll
    for (int k = 0; k < 16; ++k) { const f32x4 p = bf4(raw[k]); if (k >= 16 - win) S += p; }
#pragma unroll
    for (int j = 0; j < 16; ++j) { const int t = 16 * rq + j;
        const f32x4 p = bf4(raw[16 + j]);
        const v2u qr = (win == 2) ? raw[14 + j] : (win == 4) ? raw[12 + j] : (win == 8) ? raw[8 + j] : raw[j];
        S = S + p - bf4(qr);
        const int cn = (tpos0 + t + 1) < win ? (tpos0 + t + 1) : win; const float ic = 1.0f / (float)cn;
        const f32x4 o = S * ic - p;
        v2u w; w.x = cvt_pk_bf16(o[0], o[1]); w.y = cvt_pk_bf16(o[2], o[3]);
        *(LAS v2u*)(poolA + t * 128 + 4 * ((c4 >> 1) ^ (t & 15)) + 2 * (c4 & 1)) = w; }
}
__device__ __forceinline__ void phase3(Frame& F) {
    KArgs Ap = kargs(); struct { const float* in[23]; } A;
    A.in[I_LNG] = Ap->in[I_LNG]; A.in[I_LNB] = Ap->in[I_LNB]; A.in[I_GBS] = Ap->in[I_GBS]; A.in[I_POOLS] = Ap->in[I_POOLS];
    const float* pscale = A.in[I_POOLS];
    LAS float* lngT = (LAS float*)(F.lds + 65536); LAS float* lnbT = lngT + 1024; LAS float* gbsT = lngT + 2048;
    LAS float* ssaT = (LAS float*)(F.lds + TAB_OFF);
    LAS float* ssbT = (LAS float*)(F.lds + TAB_OFF + 2048);
    LAS float* rab = (LAS float*)(F.lds + TAB_OFF + 6144);
    const int w = F.wave;
    for (int item = F.blk; item < 256; item += F.G) {
        const int lane = lane_id(), tid = w * 64 + lane, fr = lane & 15, fq = lane >> 4;
        const int t0 = 128 * item, tpos0 = t0 & (SEQ - 1);
        unsigned char* wsp = kargs()->ws;
        const bf16* Z = (const bf16*)(wsp + WS_Z); bf16* MIX = (bf16*)(wsp + WS_MIX); const bf16* WSB = (const bf16*)(wsp + WS_WSB); const bf16* PWT = (const bf16*)(wsp + WS_PWT);
        const int wi = w >> 2, wd = w & 3;
        float ssq[4] = {0.f, 0.f, 0.f, 0.f};
        const int li = tid >> 3, cg = tid & 7;
        v4u pre[4];
        { const bf16* zp = Z + (size_t)(t0 + 2 * li) * ZW + 1024 + 16 * cg; pre[0] = *(const v4u*)zp; pre[1] = *(const v4u*)(zp + 8); pre[2] = *(const v4u*)(zp + ZW); pre[3] = *(const v4u*)(zp + ZW + 8); }
        { KArgs ap_ = kargs(); const float* lng_ = ap_->in[I_LNG]; const float* lnb_ = ap_->in[I_LNB]; const float* gbs_ = ap_->in[I_GBS];
          for (int d = tid; d < 1024; d += NTHR) { lngT[d] = lng_[d]; lnbT[d] = lnb_[d]; gbsT[d] = gbs_[d]; } }
        LDS_WAIT(); __syncthreads();
#pragma unroll 1
        for (int h = 0; h < 8; ++h) {
            LAS unsigned* vnT = (LAS unsigned*)(F.lds + (h & 1) * 32768);
            f32x4 sv[8];
            { const int sid = (item * 8 + w) * 8 + h, kb = (sid >> 7) & 31, nb = sid & 127, e = 24 + (sid >> 12);
              const float* sp = kargs()->in[I_W1] + (size_t)e * D * 4096 + (unsigned)((64 * kb + 8 * (lane >> 3)) * 4096 + 32 * nb + 4 * (lane & 7));
#pragma unroll
              for (int rr = 0; rr < 8; ++rr) sv[rr] = *(const f32x4*)(sp + rr * 4096); }
            bf16x8 afr[4][4]; v4u uw[4];
            {
                float x0[16], x1[16];
#pragma unroll
                for (int k = 0; k < 4; ++k) { x0[2 * k] = bf_lo(pre[0][k]); x0[2 * k + 1] = bf_hi(pre[0][k]); x0[8 + 2 * k] = bf_lo(pre[1][k]); x0[8 + 2 * k + 1] = bf_hi(pre[1][k]);
                                              x1[2 * k] = bf_lo(pre[2][k]); x1[2 * k + 1] = bf_hi(pre[2][k]); x1[8 + 2 * k] = bf_lo(pre[3][k]); x1[8 + 2 * k + 1] = bf_hi(pre[3][k]); }
                if (h < 7) { const bf16* zp = Z + (size_t)(t0 + 2 * li) * ZW + 1024 + 128 * (h + 1) + 16 * cg; pre[0] = *(const v4u*)zp; pre[1] = *(const v4u*)(zp + 8); pre[2] = *(const v4u*)(zp + ZW); pre[3] = *(const v4u*)(zp + ZW + 8); }
                float s0 = 0.f, s1 = 0.f;
#pragma unroll
                for (int k = 0; k < 16; ++k) { s0 += x0[k]; s1 += x1[k]; }
                s0 += __shfl_xor(s0, 1); s0 += __shfl_xor(s0, 2); s0 += __shfl_xor(s0, 4); s1 += __shfl_xor(s1, 1); s1 += __shfl_xor(s1, 2); s1 += __shfl_xor(s1, 4);
                const float m0 = s0 * (1.0f / 128.0f), m1 = s1 * (1.0f / 128.0f); float q0 = 0.f, q1 = 0.f;
#pragma unroll
                for (int k = 0; k < 16; ++k) { x0[k] -= m0; x1[k] -= m1; q0 += x0[k] * x0[k]; q1 += x1[k] * x1[k]; }
                q0 += __shfl_xor(q0, 1); q0 += __shfl_xor(q0, 2); q0 += __shfl_xor(q0, 4); q1 += __shfl_xor(q1, 1); q1 += __shfl_xor(q1, 2); q1 += __shfl_xor(q1, 4);
                const float r0 = 1.0f / sqrtf(q0 * (1.0f / 128.0f) + LN_EPS), r1 = 1.0f / sqrtf(q1 * (1.0f / 128.0f) + LN_EPS);
                const LAS float* gp = lngT + 128 * h + 16 * cg; const LAS float* bp = lnbT + 128 * h + 16 * cg;
#pragma unroll
                for (int k4 = 0; k4 < 4; ++k4) { const f32x4 g4 = *(const LAS f32x4*)(gp + 4 * k4), b4 = *(const LAS f32x4*)(bp + 4 * k4);
#pragma unroll
                    for (int k = 0; k < 4; ++k) { const int cc = 4 * k4 + k, ch = 16 * cg + cc;
                        const float y0 = x0[cc] * r0 * g4[k] + b4[k], y1 = x1[cc] * r1 * g4[k] + b4[k];
                        vnT[ch * 64 + 4 * ((li >> 2) ^ vsw(ch)) + (li & 3)] = cvt_pk_bf16(y0, y1); } }
            }
            LDS_WAIT(); __syncthreads();
            {
#pragma unroll
                for (int s = 0; s < 4; ++s) uw[s] = *(const v4u*)(Z + (size_t)(t0 + 64 * wi + 16 * s + fr) * ZW + 128 * h + 32 * wd + 8 * fq);
#pragma unroll
                for (int s = 0; s < 4; ++s)
#pragma unroll
                    for (int ks = 0; ks < 4; ++ks) afr[s][ks] = *(const bf16x8*)(WSB + ((size_t)(h * 128 + 64 * wi + 16 * s + fr) * 128 + 32 * ks + 8 * fq));
                bf16x8 bfr[2][4];
#pragma unroll
                for (int t2 = 0; t2 < 2; ++t2)
#pragma unroll
                    for (int ks = 0; ks < 4; ++ks) { const int d = 32 * wd + 8 * (fr >> 2) + 4 * t2 + (fr & 3); bfr[t2][ks] = *(const LAS bf16x8*)(vnT + d * 64 + 4 * ((4 * ks + fq) ^ vsw(d))); }
#pragma unroll
                for (int s = 0; s < 4; ++s) { const int irow = 64 * wi + 16 * s + fr;
                    f32x4 acc[2] = {{0.f, 0.f, 0.f, 0.f}, {0.f, 0.f, 0.f, 0.f}};
#pragma unroll
                    for (int ks = 0; ks < 4; ++ks)
#pragma unroll
                        for (int t2 = 0; t2 < 2; ++t2) acc[t2] = __builtin_amdgcn_mfma_f32_16x16x32_bf16(bfr[t2][ks], afr[s][ks], acc[t2], 0, 0, 0);
                    const float bsv = gbsT[h * 128 + irow];
                    v4u o4;
#pragma unroll
                    for (int t2 = 0; t2 < 2; ++t2) { const unsigned ux = t2 ? uw[s].z : uw[s].x, uy = t2 ? uw[s].w : uw[s].y;
                        const float a0 = bf_lo(ux) * (acc[t2][0] + bsv), a1 = bf_hi(ux) * (acc[t2][1] + bsv), a2 = bf_lo(uy) * (acc[t2][2] + bsv), a3 = bf_hi(uy) * (acc[t2][3] + bsv);
                        ssq[s] += (a0 * a0 + a1 * a1) + (a2 * a2 + a3 * a3);
                        if (t2) { o4.z = cvt_pk_bf16(a0, a1); o4.w = cvt_pk_bf16(a2, a3); } else { o4.x = cvt_pk_bf16(a0, a1); o4.y = cvt_pk_bf16(a2, a3); } }
                    *(v4u*)(MIX + (size_t)(t0 + irow) * D + 128 * h + 32 * wd + 8 * fq) = o4; }
            }
            { const int sid = (item * 8 + w) * 8 + h, kb = (sid >> 7) & 31, nb = sid & 127, e = 24 + (sid >> 12);
              const int n0 = 32 * nb, hf = n0 >> 11, j0 = n0 & 2047, n0p = 256 * (j0 >> 7) + 16 * ((j0 & 127) >> 3) + 8 * hf, nq = lane & 7;
              unsigned char* dp = F.ws + WS_W1T + ((size_t)e * 4096 + n0p + 16 * (nq >> 1) + 4 * (nq & 1)) * D + 64 * kb + 8 * (lane >> 3);
#pragma unroll
              for (int c = 0; c < 4; ++c) { v2u o; o.x = pg8::pk_fp8x4(sv[0][c] * pg8::W8_SCALE, sv[1][c] * pg8::W8_SCALE, sv[2][c] * pg8::W8_SCALE, sv[3][c] * pg8::W8_SCALE);
                  o.y = pg8::pk_fp8x4(sv[4][c] * pg8::W8_SCALE, sv[5][c] * pg8::W8_SCALE, sv[6][c] * pg8::W8_SCALE, sv[7][c] * pg8::W8_SCALE); *(v2u*)(dp + (size_t)c * D) = o; } }
        }
#pragma unroll
        for (int s = 0; s < 4; ++s) { float v = ssq[s]; v += __shfl_xor(v, 16); v += __shfl_xor(v, 32); if (fq == 0) ssaT[(64 * wi + 16 * s + fr) * 4 + wd] = v; }
        __syncthreads();
        float ssb[8] = {0.f, 0.f, 0.f, 0.f, 0.f, 0.f, 0.f, 0.f};
#pragma unroll 1
        for (int g = 0; g < 4; ++g) {
            LAS unsigned* poolA = (LAS unsigned*)(F.lds + (g & 1) * 65536);
            pool_stage(Z, t0, tpos0, g, w, lane, poolA);
            LDS_WAIT(); __syncthreads();
            {
                f32x4 acc[8][2];
#pragma unroll
                for (int s = 0; s < 8; ++s) { acc[s][0] = (f32x4){0.f, 0.f, 0.f, 0.f}; acc[s][1] = (f32x4){0.f, 0.f, 0.f, 0.f}; }
#pragma unroll 2
                for (int ks = 0; ks < 8; ++ks) {
                    bf16x8 bfr[2];
#pragma unroll
                    for (int t2 = 0; t2 < 2; ++t2) bfr[t2] = *(const bf16x8*)(PWT + ((size_t)(g * 256 + 32 * w + 8 * (fr >> 2) + 4 * t2 + (fr & 3)) * 256 + 32 * ks + 8 * fq));
#pragma unroll
                    for (int s = 0; s < 8; ++s) { const int t = 16 * s + fr; const bf16x8 afr = *(const LAS bf16x8*)(poolA + t * 128 + 4 * ((4 * ks + fq) ^ (t & 15)));
                        acc[s][0] = __builtin_amdgcn_mfma_f32_16x16x32_bf16(bfr[0], afr, acc[s][0], 0, 0, 0); acc[s][1] = __builtin_amdgcn_mfma_f32_16x16x32_bf16(bfr[1], afr, acc[s][1], 0, 0, 0); }
                }
                { const int dg = 256 * g + 32 * w + 8 * fq; const f32x4 ps0 = *(const f32x4*)(pscale + dg), ps1 = *(const f32x4*)(pscale + dg + 4);
#pragma unroll
                    for (int s = 0; s < 8; ++s) { const int t = 16 * s + fr; const f32x4 y0 = acc[s][0] * ps0, y1 = acc[s][1] * ps1;
                        ssb[s] += ((y0[0] * y0[0] + y0[1] * y0[1]) + (y0[2] * y0[2] + y0[3] * y0[3])) + ((y1[0] * y1[0] + y1[1] * y1[1]) + (y1[2] * y1[2] + y1[3] * y1[3]));
                        v4u o; o.x = cvt_pk_bf16(y0[0], y0[1]); o.y = cvt_pk_bf16(y0[2], y0[3]); o.z = cvt_pk_bf16(y1[0], y1[1]); o.w = cvt_pk_bf16(y1[2], y1[3]); *(v4u*)(MIX + (size_t)(t0 + t) * D + 1024 + dg) = o; } }
            }
        }
#pragma unroll
        for (int s = 0; s < 8; ++s) { float v = ssb[s]; v += __shfl_xor(v, 16); v += __shfl_xor(v, 32); if (fq == 0) ssbT[(16 * s + fr) * 8 + w] = v; }
        LDS_WAIT(); __syncthreads();
        if (tid < 128) { float sa = 0.f, sb = 0.f;
#pragma unroll
            for (int k = 0; k < 4; ++k) sa += ssaT[tid * 4 + k];
#pragma unroll
            for (int k = 0; k < 8; ++k) sb += ssbT[tid * 8 + k];
            ((float*)(F.ws + WS_RA))[t0 + tid] = 1.0f / sqrtf(sa * (1.0f / 1024.0f) + RMS_EPS); ((float*)(F.ws + WS_RB))[t0 + tid] = 1.0f / sqrtf(sb * (1.0f / 1024.0f) + RMS_EPS); }
        __syncthreads();
    }
}

__device__ __forceinline__ void phase5(Frame& F) {
    KArgs Ap = kargs(); struct { const float* in[23]; } A;
    A.in[I_RW] = Ap->in[I_RW]; A.in[I_RB] = Ap->in[I_RB]; A.in[I_FFNG] = Ap->in[I_FFNG];
    const float* w1 = Ap->in[I_W1];
    const float* mod = (const float*)(F.ws + WS_MOD); const bf16* X1 = (const bf16*)(F.ws + WS_X1); unsigned char* H2 = (unsigned char*)(F.ws + WS_H8);
    const float* rwp = (const float*)(F.ws + WS_RWP); const float* rb = A.in[I_RB]; const float* ffng = A.in[I_FFNG];
    float* lgate = (float*)(F.ws + WS_LGATE); int* list = (int*)(F.ws + WS_LIST); unsigned* cnt = (unsigned*)(F.ws + WS_CTL) + CW_CNT;
    LAS float* gsf = (LAS float*)(F.lds + TAB_OFF); LAS float* shf = gsf + D;
    LAS float* part = (LAS float*)(F.lds);
    LAS float* ssp = (LAS float*)(F.lds + 32768);
    LAS int* lcnt = (LAS int*)(F.lds + 32768 + 1024 + 2048);
    LAS int* gbase = lcnt + 32;
    LAS int* ebuf = gbase + 32;
    LAS int* lpos = ebuf + 512;
    LAS float* gbuf = (LAS float*)(lpos + 512);
    const int tid = F.tid, lane = F.lane, w = F.wave, r = lane & 15, q = lane >> 4;
    for (int item = F.blk; item < 256; item += F.G) {
        const int t0 = 128 * item, b = item >> 7;
        __syncthreads();
        for (int d = tid; d < D; d += NTHR) { gsf[d] = ffng[d] * (1.0f + mod[b * 12288 + 4 * D + d]); shf[d] = mod[b * 12288 + 3 * D + d]; }
        if (tid < 32) lcnt[tid] = 0;
        __syncthreads();
        v4u xr[4][2];
        { const bf16* xp = X1 + (size_t)(t0 + r) * D + 256 * w + 16 * q;
#pragma unroll
          for (int s = 0; s < 4; ++s) { xr[s][0] = *(const v4u*)(xp + 64 * s); xr[s][1] = *(const v4u*)(xp + 64 * s + 8); } }
        f32x4 xv[4][4];
#define P5_UNPACK(buf) do { float ss_ = 0.f; _Pragma("unroll") for (int s = 0; s < 4; ++s) _Pragma("unroll") for (int hh = 0; hh < 2; ++hh) { const v4u x = xr[s][hh]; \
            xv[s][2 * hh] = (f32x4){bf_lo(x.x), bf_hi(x.x), bf_lo(x.y), bf_hi(x.y)}; xv[s][2 * hh + 1] = (f32x4){bf_lo(x.z), bf_hi(x.z), bf_lo(x.w), bf_hi(x.w)}; \
            const f32x4 p0 = xv[s][2 * hh], p1 = xv[s][2 * hh + 1]; \
            ss_ += (p0[0] * p0[0] + p0[1] * p0[1]) + (p0[2] * p0[2] + p0[3] * p0[3]) + (p1[0] * p1[0] + p1[1] * p1[1]) + (p1[2] * p1[2] + p1[3] * p1[3]); } \
            ss_ += __shfl_xor(ss_, 16); ss_ += __shfl_xor(ss_, 32); if (q == 0) ssp[(buf) * 128 + w * 16 + r] = ss_; } while (0)
#define P5_LOADX(tokrow) do { const bf16* xp = X1 + (size_t)(tokrow) * D + 256 * w + 16 * q; _Pragma("unroll") for (int s = 0; s < 4; ++s) { xr[s][0] = *(const v4u*)(xp + 64 * s); xr[s][1] = *(const v4u*)(xp + 64 * s + 8); } } while (0)
        P5_UNPACK(0);
        P5_LOADX(t0 + 16 + r);
        LDS_WAIT(); __syncthreads();
#pragma unroll 1
        for (int grp = 0; grp < 8; ++grp) {
            const int tok = t0 + 16 * grp + r, par = grp & 1;
            f32x4 sv[8];
            { const int sid = (item * 8 + w) * 8 + grp, kb = (sid >> 7) & 31, nb = sid & 127, e = 28 + (sid >> 12);
              const float* sp = w1 + (size_t)e * D * 4096 + (unsigned)((64 * kb + 8 * (lane >> 3)) * 4096 + 32 * nb + 4 * (lane & 7));
#pragma unroll
              for (int rr = 0; rr < 8; ++rr) sv[rr] = *(const f32x4*)(sp + rr * 4096); }
            float tot = 0.f;
#pragma unroll
            for (int k = 0; k < 8; ++k) tot += ssp[par * 128 + k * 16 + r];
            const float rstd = 1.0f / sqrtf(tot * (1.0f / D) + RMS_EPS);
            unsigned char* hp = H2 + (size_t)tok * D + 256 * w + 16 * q;
#pragma unroll
            for (int s = 0; s < 4; ++s) { const int col = 256 * w + 64 * s + 16 * q; v4u o;
#pragma unroll
                for (int c = 0; c < 4; ++c) { const f32x4 g = *(const LAS f32x4*)(gsf + col + 4 * c), sh4 = *(const LAS f32x4*)(shf + col + 4 * c);
                    xv[s][c] = xv[s][c] * rstd * g + sh4; const unsigned pk = pg8::pk_fp8x4(xv[s][c][0], xv[s][c][1], xv[s][c][2], xv[s][c][3]);
                    if (c == 0) o.x = pk; else if (c == 1) o.y = pk; else if (c == 2) o.z = pk; else o.w = pk; }
                *(v4u*)(hp + 64 * s) = o; }
            f32x4 acc0 = {0.f, 0.f, 0.f, 0.f}, acc1 = {0.f, 0.f, 0.f, 0.f};
            int rwo = w * 8192 + lane * 4; asm volatile("" : "+v"(rwo));
#pragma unroll
            for (int s = 0; s < 4; ++s) {
#pragma unroll
                for (int c = 0; c < 4; ++c) { const f32x4 b0 = *(const f32x4*)(rwp + rwo + (s * 2 + 0) * 1024 + 256 * c), b1 = *(const f32x4*)(rwp + rwo + (s * 2 + 1) * 1024 + 256 * c);
#pragma unroll
                    for (int k = 0; k < 4; ++k) { const float a = xv[s][c][k];
                        acc0 = __builtin_amdgcn_mfma_f32_16x16x4f32(a, b0[k], acc0, 0, 0, 0); acc1 = __builtin_amdgcn_mfma_f32_16x16x4f32(a, b1[k], acc1, 0, 0, 0); } } }
#pragma unroll
            for (int k = 0; k < 4; ++k) { part[par * 4096 + (w * 16 + 4 * q + k) * 32 + r] = acc0[k]; part[par * 4096 + (w * 16 + 4 * q + k) * 32 + 16 + r] = acc1[k]; }
            if (grp < 7) { P5_UNPACK(par ^ 1); if (grp < 6) P5_LOADX(tok + 32); }
            { const int sid = (item * 8 + w) * 8 + grp, kb = (sid >> 7) & 31, nb = sid & 127, e = 28 + (sid >> 12);
              const int n0 = 32 * nb, hf = n0 >> 11, j0 = n0 & 2047, n0p = 256 * (j0 >> 7) + 16 * ((j0 & 127) >> 3) + 8 * hf, nq = lane & 7;
              unsigned char* dp = F.ws + WS_W1T + ((size_t)e * 4096 + n0p + 16 * (nq >> 1) + 4 * (nq & 1)) * D + 64 * kb + 8 * (lane >> 3);
#pragma unroll
              for (int c = 0; c < 4; ++c) { v2u o; o.x = pg8::pk_fp8x4(sv[0][c] * pg8::W8_SCALE, sv[1][c] * pg8::W8_SCALE, sv[2][c] * pg8::W8_SCALE, sv[3][c] * pg8::W8_SCALE);
                  o.y = pg8::pk_fp8x4(sv[4][c] * pg8::W8_SCALE, sv[5][c] * pg8::W8_SCALE, sv[6][c] * pg8::W8_SCALE, sv[7][c] * pg8::W8_SCALE); *(v2u*)(dp + (size_t)c * D) = o; } }
            LDS_WAIT(); __syncthreads();
            {
              const int tk = tid >> 5, e = tid & 31; float lg = rb[e];
#pragma unroll
              for (int k = 0; k < 8; ++k) lg += part[par * 4096 + (k * 16 + tk) * 32 + e];
              float val[4]; int idx[4]; float v = lg;
#pragma unroll
              for (int k = 0; k < 4; ++k) { float m = v; int mi = e;
#pragma unroll
                  for (int off = 16; off >= 1; off >>= 1) { const float om = __shfl_xor(m, off); const int oi = __shfl_xor(mi, off); if (om > m || (om == m && oi < mi)) { m = om; mi = oi; } }
                  val[k] = m; idx[k] = mi; if (e == mi) v = -3.0e38f; }
              float ex[4], sum = 0.f;
#pragma unroll
              for (int k = 0; k < 4; ++k) { ex[k] = __expf(val[k] - val[0]); sum += ex[k]; }
              const float inv = 1.0f / sum;
              if (e < 4) { const float gk = (e == 0 ? ex[0] : e == 1 ? ex[1] : e == 2 ? ex[2] : ex[3]) * inv; const int ik = e == 0 ? idx[0] : e == 1 ? idx[1] : e == 2 ? idx[2] : idx[3];
                  const int a = (16 * grp + tk) * 4 + e; gbuf[a] = gk; ebuf[a] = ik; lpos[a] = __hip_atomic_fetch_add(&lcnt[ik], 1, __ATOMIC_RELAXED, __HIP_MEMORY_SCOPE_WORKGROUP); } }
        }
#undef P5_UNPACK
#undef P5_LOADX
        LDS_WAIT(); __syncthreads();
        if (tid < 32) gbase[tid] = (int)__hip_atomic_fetch_add(cnt + 64 * tid, (unsigned)lcnt[tid], __ATOMIC_RELAXED, __HIP_MEMORY_SCOPE_AGENT);
        LDS_WAIT(); __syncthreads();
        { const int e = ebuf[tid]; const size_t li = (size_t)e * LCAP + gbase[e] + lpos[tid]; list[li] = t0 * 4 + tid; lgate[li] = gbuf[tid]; }
    }
}

__device__ __forceinline__ void phase8(Frame& F) {
    KArgs Ap = kargs(); struct { const float* in[23]; float* out; } A;
    A.in[I_FING] = Ap->in[I_FING]; A.out = Ap->out;
    const float* mod = (const float*)(F.ws + WS_MOD); const bf16* X1 = (const bf16*)(F.ws + WS_X1); const unsigned char* Y4 = F.ws + WS_Y4;
    const float* fing = A.in[I_FING]; float* out = A.out;
    LAS float* gfb = (LAS float*)(F.lds); LAS float* fg = gfb + 2 * D;
    __syncthreads();
    for (int d = F.tid; d < 2 * D; d += NTHR) gfb[d] = mod[(d >> 11) * 12288 + 5 * D + (d & (D - 1))] * pg8::Y8_INV;
    for (int d = F.tid; d < D; d += NTHR) fg[d] = fing[d];
    __syncthreads();
    const int gw = F.blk * NWAVES + F.wave, NGW = F.G * NWAVES;
#pragma unroll 1
    for (int tok = gw; tok < T; tok += NGW) { const LAS float* gf = gfb + (tok >= SEQ ? D : 0);
            f32x4 v[2][4]; float ss = 0.f;
            v4u yw[2][4];
#pragma unroll
            for (int j = 0; j < 2; ++j)
#pragma unroll
                for (int k = 0; k < 4; ++k) yw[j][k] = *(const v4u*)(Y4 + ((size_t)tok * 4 + k) * D + 16 * F.lane + 1024 * j);
#pragma unroll
            for (int j = 0; j < 2; ++j)
#pragma unroll
                for (int c2 = 0; c2 < 2; ++c2) { const v4u xw = *(const v4u*)(X1 + (size_t)tok * D + 16 * F.lane + 1024 * j + 8 * c2);
                    v[j][2 * c2] = (f32x4){bf_lo(xw.x), bf_hi(xw.x), bf_lo(xw.y), bf_hi(xw.y)}; v[j][2 * c2 + 1] = (f32x4){bf_lo(xw.z), bf_hi(xw.z), bf_lo(xw.w), bf_hi(xw.w)}; }
#pragma unroll
            for (int j = 0; j < 2; ++j)
#pragma unroll
                for (int c = 0; c < 4; ++c) { f32x4 y = {0.f, 0.f, 0.f, 0.f};
#pragma unroll
                    for (int k = 0; k < 4; ++k) { const f32x2 lo = __builtin_amdgcn_cvt_pk_f32_fp8((int)yw[j][k][c], false), hi = __builtin_amdgcn_cvt_pk_f32_fp8((int)yw[j][k][c], true); y += (f32x4){lo.x, lo.y, hi.x, hi.y}; }
                    const f32x4 g = *(const LAS f32x4*)(gf + 16 * F.lane + 1024 * j + 4 * c);
                    v[j][c] = v[j][c] + g * y;
                    ss += (v[j][c][0] * v[j][c][0] + v[j][c][1] * v[j][c][1]) + (v[j][c][2] * v[j][c][2] + v[j][c][3] * v[j][c][3]); }
            const float rstd = 1.0f / sqrtf(wave_sum(ss) * (1.0f / D) + RMS_EPS);
#pragma unroll
            for (int j = 0; j < 2; ++j)
#pragma unroll
                for (int c = 0; c < 4; ++c) { const int col = 16 * F.lane + 1024 * j + 4 * c;
                    *(f32x4*)(out + (size_t)tok * D + col) = v[j][c] * rstd * *(const LAS f32x4*)(fg + col); } }
}

__global__ void __launch_bounds__(NTHR, 2) mk_fwd(Args args) {
    extern __shared__ __attribute__((aligned(16))) unsigned char lds_raw[];
    Frame F;
    F.lds = (LAS unsigned char*)lds_raw; F.ws = args.ws;
    F.wave = __builtin_amdgcn_readfirstlane((int)threadIdx.x >> 6); F.G = gridDim.x; F.blk = blockIdx.x; F.vblk = F.blk;
#define REFRESH() do { F.lane = lane_id(); F.tid = F.wave * 64 + F.lane; } while (0)
    REFRESH();
    volatile LAS unsigned* MISC = (volatile LAS unsigned*)(F.lds + MISC_OFF);
    if (F.tid < 32) MISC[F.tid] = 0u;
    __syncthreads();
    unsigned* ctl = (unsigned*)(F.ws + WS_CTL);
#if MK_PER_PHASE
#define GRID_BAR() do { } while (0)
#else
    XcdBarrier bar = xcd_barrier_post(ctl + CW_BAR, MISC + 8, F.tid == 0);
#define GRID_BAR() xcd_barrier(bar, F.wave == 0 && lane_id() == 0)
#endif
    const int lo = args.ph_lo, hi = args.ph_hi;
#ifndef PH_MASK
#define PH_MASK 0x1ff
#endif
#define IN(k) (((PH_MASK >> (k)) & 1) && lo <= (k) && (k) < hi)
#define BOTH(k) (IN(k) && IN((k) + 1))
#ifndef REP_MASK
#define REP_MASK 0
#endif
#define REP(k) ((REP_MASK >> (k)) & 1)

    if (IN(0)) { REFRESH(); KArgs Ap = kargs(); phase0(F, Ap->in[I_C], Ap->in[I_WADA]); if (BOTH(0)) GRID_BAR(); if (REP(0)) { phase0(F, Ap->in[I_C], Ap->in[I_WADA]); GRID_BAR(); } }
#if !MK_PER_PHASE
    if (BOTH(0)) { if (F.wave == 0 && lane_id() == 0) { bool even = (F.G % 8) == 0; for (unsigned j = 0; j < 8; ++j) even = even && (xb_ld(&bar.bar[XB_XCNT(j)]) == (unsigned)F.G / 8u); MISC[12] = even ? (bar.x + 8u * MISC[10]) : (unsigned)F.blk; }
        __syncthreads(); F.vblk = (int)MISC[12]; }
#endif
    if (IN(1)) { REFRESH(); phase1(F); if (BOTH(1)) GRID_BAR(); if (REP(1)) { REFRESH(); phase1(F); GRID_BAR(); } }
    if (IN(2)) {
      const bool cv_first = (F.vblk & 1) == 0;
#pragma unroll 1
      for (int st_ = 0; st_ < 3; ++st_) {
        if (st_ == 1) {
          typedef pg8::DenseSched<4096, WS_H, WS_WIN, T / 256, ZW / 256> Sch; Sch S{F.G, F.vblk}; pg8::EpiZ E;
          typedef pg8::AuxW1<21, 6> AX; const AX X{F.blk * NWAVES + F.wave};
          const int done = pg8::gemm_phase<pg8::EpiZ, Sch, true, true, false, AX>(F.lds + RING_OFF, S, E, F.wave, X);
#pragma unroll 1
          for (int j = done; j < AX::NSL; ++j) { f32x4 v[8]; const int ln_ = lane_id(); X.issue(v, j, F.wave, ln_); X.consume(v, j, F.wave, ln_); }
        } else if ((st_ == 0) == cv_first) { REFRESH(); convert_big(F, cv_first); __syncthreads(); }
      }
      if (BOTH(2)) GRID_BAR();
    }
    if (IN(3)) { REFRESH(); phase3(F); if (BOTH(3)) GRID_BAR(); if (REP(3)) { REFRESH(); phase3(F); GRID_BAR(); } }
    if (IN(4)) {
#pragma unroll 1
      for (int rp_ = 0; rp_ < (REP(4) ? 2 : 1); ++rp_) {
        typedef pg8::DenseSched<4096, WS_MIX, WS_WOUT, T / 256, D / 256, true> Sch; Sch S{F.G, F.vblk}; pg8::EpiRes E;
        pg8::gemm_phase<pg8::EpiRes, Sch, true, true, false>(F.lds + RING_OFF, S, E, F.wave);
        if (BOTH(4)) GRID_BAR();
      }
    }
    if (IN(5)) { REFRESH(); phase5(F); if (BOTH(5)) GRID_BAR(); }
    if (IN(6) || IN(7)) {
        REFRESH();
        LAS int* tstart = (LAS int*)(F.lds + MOE_OFF); LAS int* ecnt = tstart + 40;
        if (F.tid < 64) { int n = 0; if (F.tid < NE) n = (int)__hip_atomic_load(ctl + CW_CNT + 64 * F.tid, __ATOMIC_RELAXED, __HIP_MEMORY_SCOPE_AGENT);
            int tiles = (n + 255) >> 8, incl = tiles;
#pragma unroll
            for (int o = 1; o < 32; o <<= 1) { const int v = __shfl_up(incl, o); if ((F.tid & 63) >= o) incl += v; }
            if (F.tid < NE) { tstart[F.tid] = incl - tiles; ecnt[F.tid] = n; }
            if (F.tid == NE - 1) tstart[NE] = incl; }
        LDS_WAIT(); __syncthreads();
        const int ntiles = __builtin_amdgcn_readfirstlane(tstart[NE]);
        if (IN(6)) {
          {
            typedef pg8::MoeSched<true, 2048, WS_H8, WS_W1T, (size_t)4096 * D, 16> Sch; Sch S{ntiles, F.G, F.vblk}; pg8::EpiSwiglu E;
            const pg8::AuxW2 X{F.blk * NWAVES + F.wave};
            const int done = pg8::gemm_phase<pg8::EpiSwiglu, Sch, true, true, true, pg8::AuxW2>(F.lds + RING_OFF, S, E, F.wave, X);
#pragma unroll 1
            for (int j = done; j < pg8::AuxW2::NSL; ++j) { f32x4 v[8]; const int ln_ = lane_id(); X.issue(v, j, F.wave, ln_); X.consume(v, j, F.wave, ln_); }
            if (BOTH(6)) GRID_BAR();
            if (REP(6)) { pg8::gemm_phase<pg8::EpiSwiglu, Sch, true, true, true>(F.lds + RING_OFF, S, E, F.wave); GRID_BAR(); }
          }
        }
        if (IN(7)) {
          {
            typedef pg8::MoeSched<false, 2048, WS_ACT, WS_W2T, (size_t)D * D, 8> Sch; Sch S{ntiles, F.G, F.vblk}; pg8::EpiY E;
            pg8::gemm_phase<pg8::EpiY, Sch, true, true, true>(F.lds + RING_OFF, S, E, F.wave);
            if (BOTH(7)) GRID_BAR();
            if (REP(7)) { pg8::gemm_phase<pg8::EpiY, Sch, true, true, true>(F.lds + RING_OFF, S, E, F.wave); GRID_BAR(); }
          }
        }
    }
    if (IN(8)) { REFRESH(); phase8(F); if (REP(8)) { GRID_BAR(); REFRESH(); phase8(F); } }
#undef IN
#undef BOTH
}

extern "C" void kernel_launch(void* const* d_in, const int* in_sizes, int n_in, void* d_out, int out_size, void* d_ws, size_t ws_size, hipStream_t stream) {
    static int grid = 0;
    if (grid == 0) {
        if (n_in != 23 || out_size != T * D || ws_size < WS_END) { fprintf(stderr, "kernel_launch: unexpected shapes (n_in %d out %d ws %zu)\n", n_in, out_size, ws_size); grid = -1; return; }
        int dev = 0, cus = 0, per_cu = 0;
        if (hipGetDevice(&dev) != hipSuccess || hipDeviceGetAttribute(&cus, hipDeviceAttributeMultiprocessorCount, dev) != hipSuccess) { grid = -1; return; }
        if (hipFuncSetAttribute((const void*)mk_fwd, hipFuncAttributeMaxDynamicSharedMemorySize, LDS_BYTES) != hipSuccess) { fprintf(stderr, "kernel_launch: hipFuncSetAttribute failed\n"); grid = -1; return; }
        if (hipOccupancyMaxActiveBlocksPerMultiprocessor(&per_cu, (const void*)mk_fwd, NTHR, LDS_BYTES) != hipSuccess || per_cu < 1) fprintf(stderr, "kernel_launch: occupancy query says %d\n", per_cu);
        (void)hipGetLastError();
        grid = cus;
    }
    if (grid < 0) return;
    if (hipMemsetAsync((char*)d_ws + WS_CTL, 0, CTL_ZERO_BYTES, stream) != hipSuccess) return;
    Args a{};
    for (int i = 0; i < 23; ++i) a.in[i] = (const float*)d_in[i];
    a.out = (float*)d_out; a.ws = (unsigned char*)d_ws;
#if MK_PER_PHASE
    for (int ph = 0; ph < 9; ++ph) { a.ph_lo = ph; a.ph_hi = ph + 1; hipLaunchKernelGGL(mk_fwd, dim3(grid), dim3(NTHR), LDS_BYTES, stream, a); }
#else
    a.ph_lo = 0; a.ph_hi = 9; hipLaunchKernelGGL(mk_fwd, dim3(grid), dim3(NTHR), LDS_BYTES, stream, a);
#endif
    (void)in_sizes;
}
```

```cpp
#include <hip/hip_runtime.h>
#include <cstdio>
#include <cstdint>

#ifndef MK_PER_PHASE
#define MK_PER_PHASE 0
#endif

#define GAS __attribute__((address_space(1)))
#define LAS __attribute__((address_space(3)))
typedef unsigned short bf16;
typedef unsigned v4u __attribute__((ext_vector_type(4)));
typedef unsigned v2u __attribute__((ext_vector_type(2)));
typedef float f32x4 __attribute__((ext_vector_type(4)));
typedef float f32x2 __attribute__((ext_vector_type(2)));
typedef short bf16x8 __attribute__((ext_vector_type(8)));

constexpr int NB = 2, SEQ = 16384, T = NB * SEQ, D = 2048, ZW = 3072, NE = 32, TOPK = 4;
constexpr int LCAP = 32768;
constexpr int MAXTILES = T * TOPK / 256 + NE;
constexpr float RMS_EPS = 1e-5f, LN_EPS = 1e-5f;
constexpr int NWAVES = 8, NTHR = 512;

constexpr size_t MiB = 1u << 20;
constexpr size_t WS_CTL = 0, CTL_ZERO_BYTES = 1 * MiB;
constexpr size_t WS_MODP = 1 * MiB;
constexpr size_t WS_MOD = 1 * MiB + 512 * 1024;
constexpr size_t WS_WSB = 2 * MiB;
constexpr size_t WS_PWT = 3 * MiB;
constexpr size_t WS_WIN = 4 * MiB;
constexpr size_t WS_WOUT = 16 * MiB;
constexpr size_t WS_RA = 296 * MiB, WS_RB = 297 * MiB;
constexpr size_t WS_RWP = 298 * MiB;
constexpr size_t WS_LGATE = 288 * MiB;

constexpr size_t WS_LIST = 26 * MiB;
constexpr size_t WS_W1T = 32 * MiB;
constexpr size_t WS_W2T = 544 * MiB;
constexpr size_t WS_H = 800 * MiB;
constexpr size_t WS_H8 = 864 * MiB;
constexpr size_t WS_Z = 928 * MiB;
constexpr size_t WS_MIX = 1120 * MiB;
constexpr size_t WS_X1 = 1248 * MiB;
constexpr size_t WS_ACT = 1504 * MiB;
constexpr size_t WS_Y4 = 2048 * MiB;
constexpr size_t WS_END = 2560 * MiB;
constexpr int CW_BAR = 4096;
constexpr int CW_CNT = 16384;

constexpr int RING_OFF = 0, RING_BYTES = 131072;
constexpr int TAB_OFF = 131072;
constexpr int ROWTAB_OFF = 147456;
constexpr int MOE_OFF = 149504;
constexpr int MISC_OFF = 150016;
constexpr int TBL_OFF = 150528;
constexpr int LDS_BYTES = 156672;

#define LDS_WAIT() asm volatile("s_waitcnt lgkmcnt(0)" ::: "memory")
#define VM_WAIT() asm volatile("s_waitcnt vmcnt(0)" ::: "memory")

__device__ __forceinline__ unsigned cvt_pk_bf16(float lo, float hi) { unsigned r; asm("v_cvt_pk_bf16_f32 %0, %1, %2" : "=v"(r) : "v"(lo), "v"(hi)); return r; }
__device__ __forceinline__ float bf_lo(unsigned w) { return __uint_as_float(w << 16); }
__device__ __forceinline__ float bf_hi(unsigned w) { return __uint_as_float(w & 0xffff0000u); }
__device__ __forceinline__ int lane_id() { int l; asm volatile("v_mbcnt_lo_u32_b32 %0, -1, 0\n\tv_mbcnt_hi_u32_b32 %0, -1, %0" : "=v"(l)); return l; }
__device__ __forceinline__ float wave_sum(float v) {
#pragma unroll
    for (int o = 1; o < 64; o <<= 1) v += __shfl_xor(v, o);
    return v;
}

#define XB_TMO      128
#define XB_XCNT(j)  (256  + 64 * (j))
#define XB_XSUB(j)  (1280 + 64 * (j))
#define XB_XGEN(j)  (2304 + 64 * (j))
#define XB_TOP      3328
#define XB_TOPGEN   3392
#define XCD_BAR_WORDS 3456
#define XB_SPIN_CAP (1u << 18)
__device__ __forceinline__ unsigned xb_ld(unsigned* p)              { return __hip_atomic_load(p, __ATOMIC_RELAXED, __HIP_MEMORY_SCOPE_AGENT); }
__device__ __forceinline__ unsigned xb_add(unsigned* p, unsigned v) { return __hip_atomic_fetch_add(p, v, __ATOMIC_RELAXED, __HIP_MEMORY_SCOPE_AGENT); }
__device__ __forceinline__ unsigned xb_xcc_id() { return (unsigned)__builtin_amdgcn_s_getreg((3 << 11) | 20) & 0xFu; }
#define XB_SPIN(cond, bar) do { unsigned _sp = 0; while (cond) { __builtin_amdgcn_s_sleep(1); \
    if ((++_sp & 255u) == 0u) { if (xb_ld(&(bar)[XB_TMO])) break; if (_sp > XB_SPIN_CAP) { atomicAdd(&(bar)[XB_TMO], 1u); break; } } } } while (0)
struct XcdBarrier { unsigned* bar; unsigned x; volatile LAS unsigned* st; };
__device__ __forceinline__ XcdBarrier xcd_barrier_post(unsigned* bar, volatile LAS unsigned* st, bool leader) {
    XcdBarrier b; b.bar = bar; b.x = xb_xcc_id(); b.st = st;
    if (leader) st[2] = xb_add(&bar[XB_XCNT(b.x)], 1u);
    return b;
}
__device__ __forceinline__ void xcd_barrier_complete(unsigned* bar, unsigned x, unsigned& nloc, unsigned& nx) {
    const unsigned G = gridDim.x * gridDim.y * gridDim.z;
    unsigned sum, cnt, mine, sp = 0u;
    for (;;) {
        sum = 0u; cnt = 0u; mine = 0u;
#pragma unroll
        for (unsigned j = 0; j < 16; ++j) { const unsigned c = xb_ld(&bar[XB_XCNT(j)]); sum += c; cnt += (c > 0u) ? 1u : 0u; mine = (j == x) ? c : mine; }
        if (sum == G) break;
        __builtin_amdgcn_s_sleep(1);
        if ((++sp & 255u) == 0u) { if (xb_ld(&bar[XB_TMO])) break; if (sp > XB_SPIN_CAP) { atomicAdd(&bar[XB_TMO], 1u); break; } }
    }
    nloc = mine > 0u ? mine : 1u; nx = cnt > 0u ? cnt : 1u;
}
__device__ __forceinline__ void xcd_barrier(const XcdBarrier& b, bool leader) {
    asm volatile("s_waitcnt vmcnt(0)" ::: "memory");
    __syncthreads();
    if (leader) {
        unsigned* bar = b.bar;
        __builtin_amdgcn_s_waitcnt(0);
        unsigned nloc = b.st[0], nx = b.st[1];
        if (nloc == 0u) { xcd_barrier_complete(bar, b.x, nloc, nx); b.st[0] = nloc; b.st[1] = nx; }
        const unsigned old = xb_add(&bar[XB_XSUB(b.x)], 1u);
        const unsigned gen = old / nloc;
        if (old + 1u == (gen + 1u) * nloc) {
            __builtin_amdgcn_fence(__ATOMIC_RELEASE, "agent");
            asm volatile("s_waitcnt vmcnt(0)" ::: "memory");
            const unsigned og = xb_add(&bar[XB_TOP], 1u);
            const unsigned tg = og / nx;
            if (og + 1u == (tg + 1u) * nx) xb_add(&bar[XB_TOPGEN], 1u);
            else XB_SPIN(xb_ld(&bar[XB_TOPGEN]) == tg, bar);
            __builtin_amdgcn_fence(__ATOMIC_ACQUIRE, "agent");
            xb_add(&bar[XB_XGEN(b.x)], 1u);
            asm volatile("s_waitcnt vmcnt(0)" ::: "memory");
        } else {
            XB_SPIN(xb_ld(&bar[XB_XGEN(b.x)]) == gen, bar);
            __builtin_amdgcn_fence(__ATOMIC_ACQUIRE, "agent");
            asm volatile("s_waitcnt vmcnt(0)" ::: "memory");
        }
    }
    __syncthreads();
}

struct Args { const float* in[23]; float* out; unsigned char* ws; int ph_lo, ph_hi; };
enum { I_X = 0, I_C, I_MIXG, I_WADA, I_BADA, I_WIN, I_LNG, I_LNB, I_GWS, I_GBS, I_POOLW, I_POOLS, I_GOUTG, I_POUTG, I_WOUT, I_FFNG, I_RW, I_RB, I_W1, I_B1, I_W2, I_B2, I_FING };

typedef __attribute__((address_space(4))) const Args* KArgs;
__device__ __forceinline__ KArgs kargs() { KArgs p = (KArgs)__builtin_amdgcn_kernarg_segment_ptr(); asm volatile("" : "+s"(p)); return p; }
namespace pg8 {
constexpr int BM = 256, BK = 64, HALF = 128, HTB = HALF * BK * 2, STAGE_BYTES = 8 * HTB, NXCD = 8, WGM = 8;
constexpr int K = 2048, NT = K / BK;
__host__ __device__ __forceinline__ int lds_byte(int r, int c) { const int st = (r >> 4) * 2 + (c >> 5), rr = r & 15, cc = c & 31, ob = rr * 64 + cc * 2; return st * 1024 + (ob ^ (((ob >> 9) & 1) << 5)); }
__host__ __device__ __forceinline__ void stage_rc(int b, int& R, int& C) { const int st = b / 1024, sb = b % 1024, swz = sb ^ (((sb >> 9) & 1) << 5); R = (st >> 1) * 16 + swz / 64; C = (st & 1) * 32 + (swz % 64) / 2; }
__host__ __device__ __forceinline__ int lds_byte8(int r, int cb) { const int st = (r >> 4) * 2 + (cb >> 6), rr = r & 15, ob = rr * 64 + (cb & 63); return st * 1024 + (ob ^ (((ob >> 9) & 1) << 4)); }
__host__ __device__ __forceinline__ void stage_rc8(int b, int& R, int& Cb) { const int st = b / 1024, sb = b % 1024, swz = sb ^ (((sb >> 9) & 1) << 4); R = (st >> 1) * 16 + swz / 64; Cb = (st & 1) * 64 + (swz % 64); }
typedef int v4i __attribute__((ext_vector_type(4)));
typedef int v8i __attribute__((ext_vector_type(8)));
__device__ __forceinline__ unsigned pk_fp8x4(float a, float b, float c, float d) { int w = 0; w = __builtin_amdgcn_cvt_pk_fp8_f32(a, b, w, false); w = __builtin_amdgcn_cvt_pk_fp8_f32(c, d, w, true); return (unsigned)w; }
constexpr float Y8_SCALE = 8.0f, Y8_INV = 1.0f / 8.0f;
constexpr float W8_SCALE = 256.0f, W8_INV = 1.0f / 256.0f;
__host__ __device__ __forceinline__ int perm32(int rho) { const int n = rho >> 4, i = rho & 15; return 8 * (i >> 2) + 4 * n + (i & 3); }

struct Unit { int pm, pn, e, ml; };

__device__ __forceinline__ bool order_next(int i, int G, int c, int nM, int nN, Unit& u) {
    const int nwg = nM * nN; const int L = i * G + c; if (L >= nwg) return false;
    int wgid = L; { const int q = nwg / NXCD, r = nwg % NXCD, xcd = wgid % NXCD, off = wgid / NXCD; wgid = (xcd < r ? xcd * (q + 1) : r * (q + 1) + (xcd - r) * q) + off; }
    const int nig = WGM * nN, gid = wgid / nig, fm = gid * WGM, gsz = (nM - fm) < WGM ? (nM - fm) : WGM;
    u.pm = fm + ((wgid % nig) % gsz); u.pn = (wgid % nig) / gsz; u.e = 0; u.ml = 0; return true;
}
template <int ROWB, size_t WS_A, size_t WS_B, int NM, int NN, bool ROWFAC = false> struct DenseSched {
    int G, c;
    __device__ __forceinline__ bool next(int i, Unit& u) const { return order_next(i, G, c, NM, NN, u); }
    __device__ __forceinline__ const char* a_base() const { return (const char*)(kargs()->ws + WS_A); }
    __device__ __forceinline__ const char* b_ptr(const Unit& u) const { return (const char*)(kargs()->ws + WS_B) + (size_t)u.pn * (256 * ROWB); }
    __device__ __forceinline__ bool need_prep(const Unit&, const Unit&) const { return false; }
    __device__ __forceinline__ void prep(const Unit&, int, int) const {}
    __device__ __forceinline__ void tables(const Unit& u, int eslot, int wid, int lane) const {
        if (ROWFAC) { if (wid < 2) { const char* src = (const char*)(kargs()->ws + (wid == 0 ? WS_RA : WS_RB)) + (size_t)u.pm * 1024 + 16 * lane;
                __builtin_amdgcn_global_load_lds((const unsigned*)src, (LAS unsigned*)(size_t)(TBL_OFF + eslot * 3072 + 1024 * wid), 16, 0, 0); } }
    }
    __device__ __forceinline__ void a_off(const Unit& u, int, const int (&Ri)[2], const int (&Ci2)[2], unsigned (&o)[2][2]) const {
#pragma unroll
        for (int h = 0; h < 2; ++h)
#pragma unroll
            for (int i = 0; i < 2; ++i) o[h][i] = (unsigned)(u.pm * 256 + h * 128 + Ri[i]) * (unsigned)ROWB + (unsigned)Ci2[i];
    }
};
template <bool GATHER, int ROWB, size_t WS_A, size_t WS_B, size_t BSTRIDE, int NN> struct MoeSched {
    int nM, G, c;
    __device__ __forceinline__ static const LAS int* tstart() { return (const LAS int*)(size_t)MOE_OFF; }
    __device__ __forceinline__ static const LAS int* ecnt() { return (const LAS int*)(size_t)(MOE_OFF + 160); }
    __device__ __forceinline__ static LAS unsigned* rowtab() { return (LAS unsigned*)(size_t)ROWTAB_OFF; }
    __device__ __forceinline__ bool next(int i, Unit& u) const {
        if (!order_next(i, G, c, nM, NN, u)) return false;
        int e = 0;
#pragma unroll
        for (int k = 1; k < NE; ++k) e += (tstart()[k] <= u.pm) ? 1 : 0;
        e = __builtin_amdgcn_readfirstlane(e);
        u.e = e; u.ml = u.pm - __builtin_amdgcn_readfirstlane(tstart()[e]); return true;
    }
    __device__ __forceinline__ const char* a_base() const { return (const char*)(kargs()->ws + WS_A); }
    __device__ __forceinline__ const char* b_ptr(const Unit& u) const { return (const char*)(kargs()->ws + WS_B) + (size_t)u.e * BSTRIDE + (size_t)u.pn * (256 * ROWB); }
    __device__ __forceinline__ bool need_prep(const Unit& a, const Unit& b) const { return GATHER && (a.pm != b.pm); }
    __device__ __forceinline__ void prep(const Unit& u, int slot, int tid) const {
        if (GATHER) {
            if (tid < 256) { const int* list = (const int*)(kargs()->ws + WS_LIST); const int a = 256 * u.ml + tid; const int n = ecnt()[u.e]; int ent = 0; if (a < n) ent = list[(size_t)u.e * LCAP + a];
                rowtab()[slot * 256 + tid] = (unsigned)(ent >> 2) * (unsigned)ROWB; } }
    }
    __device__ __forceinline__ void tables(const Unit& u, int eslot, int wid, int lane) const {
        KArgs ap = kargs(); LAS unsigned char* tb = (LAS unsigned char*)(size_t)(TBL_OFF + eslot * 3072);
        if (GATHER) { if (wid == 0) { const float* src = ap->in[I_B1] + (size_t)u.e * 4096 + (lane < 32 ? 128 * u.pn + 4 * lane : 2048 + 128 * u.pn + 4 * (lane - 32));
                __builtin_amdgcn_global_load_lds((const unsigned*)src, (LAS unsigned*)tb, 16, 0, 0); } }
        else { if (wid < 3) { const char* src = wid == 0 ? (const char*)(ap->in[I_B2] + (size_t)u.e * D + 256 * u.pn) : (const char*)(ap->ws + (wid == 1 ? WS_LIST : WS_LGATE)) + ((size_t)u.e * LCAP + 256 * u.ml) * 4;
                __builtin_amdgcn_global_load_lds((const unsigned*)(src + 16 * lane), (LAS unsigned*)(tb + 1024 * wid), 16, 0, 0); } }
    }
    __device__ __forceinline__ void a_off(const Unit& u, int slot, const int (&Ri)[2], const int (&Ci2)[2], unsigned (&o)[2][2]) const {
#pragma unroll
        for (int h = 0; h < 2; ++h)
#pragma unroll
            for (int i = 0; i < 2; ++i) {
                if (GATHER) o[h][i] = rowtab()[slot * 256 + h * 128 + Ri[i]] + (unsigned)Ci2[i];
                else o[h][i] = (unsigned)(u.pm * 256 + h * 128 + Ri[i]) * (unsigned)ROWB + (unsigned)Ci2[i];
            }
    }
};

__device__ __forceinline__ f32x2 gelu_pk(f32x2 v) {
    const f32x2 av = __builtin_elementwise_abs(v), d = av * 0.2316418882f + 1.0f;
    f32x2 t; t.x = __builtin_amdgcn_rcpf(d.x); t.y = __builtin_amdgcn_rcpf(d.y);
    f32x2 q = t * 0.5307027145f + (-0.7265760135f); q = q * t + 0.7107068705f; q = q * t + (-0.142248368f); q = q * t + 0.127414796f; q = q * t;
    const f32x2 s = (v * v) * (-0.72134752044f);
    f32x2 e; e.x = __builtin_amdgcn_exp2f(s.x); e.y = __builtin_amdgcn_exp2f(s.y);
    const f32x2 m = v * (q * e), r = v - m;
    f32x2 o; o.x = v.x < 0.f ? m.x : r.x; o.y = v.y < 0.f ? m.y : r.y; return o;
}

struct EpiZ {
    static constexpr bool PERM = true, HAS_MID = false;
    __device__ __forceinline__ void operator()(const f32x4 (&acc)[2][2][4][2], const Unit& u, int wr, int wc, int fr, int fq, int eslot) const {
        bf16* Z = (bf16*)(kargs()->ws + WS_Z);
        const int row0 = u.pm * BM + wr * 64 + fr, col0 = u.pn * BM + wc * 64 + 16 * fq; const bool act = u.pn < 8;
#pragma unroll
        for (int ai = 0; ai < 2; ++ai)
#pragma unroll
            for (int m = 0; m < 4; ++m) { bf16* rowp = Z + (size_t)(row0 + ai * HALF + m * 16) * ZW + col0;
#pragma unroll
                for (int bj = 0; bj < 2; ++bj) { f32x4 v0 = acc[ai][bj][m][0], v1 = acc[ai][bj][m][1];
                    if (act) { f32x2 a = gelu_pk((f32x2){v0[0], v0[1]}), b = gelu_pk((f32x2){v0[2], v0[3]}), c = gelu_pk((f32x2){v1[0], v1[1]}), d = gelu_pk((f32x2){v1[2], v1[3]});
                        v0 = (f32x4){a.x, a.y, b.x, b.y}; v1 = (f32x4){c.x, c.y, d.x, d.y}; }
                    v4u w; w.x = cvt_pk_bf16(v0[0], v0[1]); w.y = cvt_pk_bf16(v0[2], v0[3]); w.z = cvt_pk_bf16(v1[0], v1[1]); w.w = cvt_pk_bf16(v1[2], v1[3]);
                    *(v4u*)(rowp + bj * 8) = w; } }
    }
};
struct EpiRes {
    static constexpr bool PERM = true, HAS_MID = true;
    __device__ __forceinline__ void mid(f32x4 (&acc)[2][2][4][2], int wr, int fr, int eslot) const {
        const LAS float* ra = (const LAS float*)(size_t)(TBL_OFF + eslot * 3072); const LAS float* rb = ra + 256;
#pragma unroll
        for (int ai = 0; ai < 2; ++ai)
#pragma unroll
            for (int m = 0; m < 4; ++m) { const int r = ai * HALF + wr * 64 + m * 16 + fr; const float f = ra[r] * __builtin_amdgcn_rcpf(rb[r]);
#pragma unroll
                for (int bj = 0; bj < 2; ++bj)
#pragma unroll
                    for (int n = 0; n < 2; ++n) acc[ai][bj][m][n] = acc[ai][bj][m][n] * f; }
    }
    __device__ __forceinline__ void operator()(const f32x4 (&acc)[2][2][4][2], const Unit& u, int wr, int wc, int fr, int fq, int eslot) const {
        KArgs ap = kargs(); const float* x = ap->in[I_X]; bf16* x1 = (bf16*)(ap->ws + WS_X1); const float* mod = (const float*)(ap->ws + WS_MOD);
        const int row0 = u.pm * BM + wr * 64 + fr, col0 = u.pn * BM + wc * 64 + 16 * fq; const int b = (u.pm * BM) >= SEQ ? 1 : 0;
        f32x4 gm[2][2];
#pragma unroll
        for (int bj = 0; bj < 2; ++bj)
#pragma unroll
            for (int n = 0; n < 2; ++n) gm[bj][n] = *(const f32x4*)(mod + b * 12288 + 2 * D + col0 + bj * 8 + 4 * n);
#pragma unroll
        for (int ai = 0; ai < 2; ++ai) {
            f32x4 xs[4][2][2];
#pragma unroll
            for (int m = 0; m < 4; ++m)
#pragma unroll
                for (int bj = 0; bj < 2; ++bj) { const float* xp = x + (size_t)(row0 + ai * HALF + m * 16) * D + col0 + bj * 8; xs[m][bj][0] = *(const f32x4*)xp; xs[m][bj][1] = *(const f32x4*)(xp + 4); }
            asm volatile("" ::: "memory");
#pragma unroll
            for (int m = 0; m < 4; ++m) { const size_t off = (size_t)(row0 + ai * HALF + m * 16) * D + col0; const float rbv = ((const LAS float*)(size_t)(TBL_OFF + eslot * 3072 + 1024))[ai * HALF + wr * 64 + m * 16 + fr];
#pragma unroll
                for (int bj = 0; bj < 2; ++bj) {
                    const f32x4 o0 = xs[m][bj][0] + gm[bj][0] * (acc[ai][bj][m][0] * rbv), o1 = xs[m][bj][1] + gm[bj][1] * (acc[ai][bj][m][1] * rbv);
                    v4u w; w.x = cvt_pk_bf16(o0[0], o0[1]); w.y = cvt_pk_bf16(o0[2], o0[3]); w.z = cvt_pk_bf16(o1[0], o1[1]); w.w = cvt_pk_bf16(o1[2], o1[3]);
                    *(v4u*)(x1 + off + bj * 8) = w; }
                __builtin_amdgcn_sched_barrier(0); }
            asm volatile("" ::: "memory");
        }
    }
};
struct EpiSwiglu {
    static constexpr bool PERM = true, HAS_MID = false, HALVES = true;
    template <int AI> __device__ __forceinline__ void half(const f32x4 (&acc)[2][2][4][2], const Unit& u, int wr, int wc, int fr, int fq, int eslot) const {
        KArgs ap = kargs(); unsigned char* ACT = ap->ws + WS_ACT;
        const LAS float* btab = (const LAS float*)(size_t)(TBL_OFF + eslot * 3072) + wc * 32 + 8 * fq;
        const int row0 = u.pm * BM + wr * 64 + fr, colj = u.pn * HALF + wc * 32 + 8 * fq;
        constexpr int ai = AI;
#pragma unroll
            for (int m = 0; m < 4; ++m) { unsigned char* rowp = ACT + (size_t)(row0 + ai * HALF + m * 16) * D + colj; unsigned ow[2];
#pragma unroll
                for (int n = 0; n < 2; ++n) { const f32x4 g4 = acc[ai][0][m][n] * W8_INV + *(const LAS f32x4*)(btab + 4 * n), l4 = acc[ai][1][m][n] * W8_INV + *(const LAS f32x4*)(btab + 128 + 4 * n); float o[4];
#pragma unroll
                    for (int j = 0; j < 4; ++j) { const float g = fminf(g4[j], 7.0f), l = fminf(fmaxf(l4[j], -7.0f), 7.0f);
                        const float sg = __builtin_amdgcn_rcpf(1.0f + __builtin_amdgcn_exp2f(-2.45546696f * g)); o[j] = g * sg * (l + 1.0f); }
                    ow[n] = pk_fp8x4(o[0], o[1], o[2], o[3]); }
                v2u w; w.x = ow[0]; w.y = ow[1];
                *(v2u*)rowp = w; }
    }
    __device__ __forceinline__ void operator()(const f32x4 (&acc)[2][2][4][2], const Unit& u, int wr, int wc, int fr, int fq, int eslot) const {
        half<0>(acc, u, wr, wc, fr, fq, eslot); half<1>(acc, u, wr, wc, fr, fq, eslot);
    }
};
struct EpiY {
    static constexpr bool PERM = true, HAS_MID = false;
    __device__ __forceinline__ void operator()(const f32x4 (&acc)[2][2][4][2], const Unit& u, int wr, int wc, int fr, int fq, int eslot) const {
        KArgs ap = kargs(); unsigned char* Y4 = ap->ws + WS_Y4;
        const LAS float* btab = (const LAS float*)(size_t)(TBL_OFF + eslot * 3072) + wc * 64 + 16 * fq;
        const LAS int* etab = (const LAS int*)(size_t)(TBL_OFF + eslot * 3072 + 1024); const LAS float* gtab = (const LAS float*)(size_t)(TBL_OFF + eslot * 3072 + 2048);
        const int col0 = u.pn * BM + wc * 64 + 16 * fq; const int n_e = ((const LAS int*)(size_t)(MOE_OFF + 160))[u.e];
#pragma unroll
        for (int ai = 0; ai < 2; ++ai)
#pragma unroll
            for (int m = 0; m < 4; ++m) { const int r = ai * HALF + wr * 64 + m * 16 + fr;
                if (256 * u.ml + r < n_e) { const int ent = etab[r]; const float gt = gtab[r] * Y8_SCALE; unsigned char* rowp = Y4 + (size_t)ent * D + col0;
                    v4u w;
#pragma unroll
                    for (int bj = 0; bj < 2; ++bj) { const f32x4 b0 = *(const LAS f32x4*)(btab + bj * 8), b1 = *(const LAS f32x4*)(btab + bj * 8 + 4);
                        const f32x4 v0 = (acc[ai][bj][m][0] * W8_INV + b0) * gt, v1 = (acc[ai][bj][m][1] * W8_INV + b1) * gt;
                        w[2 * bj] = pk_fp8x4(v0[0], v0[1], v0[2], v0[3]); w[2 * bj + 1] = pk_fp8x4(v1[0], v1[1], v1[2], v1[3]); }
                    *(v4u*)rowp = w; } }
    }
};

struct AuxNone { static constexpr bool ON = false; int nsl = 0;
    __device__ __forceinline__ void issue(f32x4 (&)[8], int, int, int) const {} __device__ __forceinline__ void consume(const f32x4 (&)[8], int, int, int) const {} };
struct AuxW2 { static constexpr bool ON = true; static constexpr int TOTAL = 65536; int gw, ngw, nsl;
    __device__ __forceinline__ static void coords(int sid, int lane, int& e, int& k0, int& n0) { const int nb = sid & 63, kb = (sid >> 6) & 31; e = sid >> 11; k0 = 64 * kb + 8 * (lane >> 3); n0 = 32 * nb + 4 * (lane & 7); }
    __device__ __forceinline__ int sid_of(int j) const { const int sid = gw + ngw * j; return sid < TOTAL ? sid : TOTAL - 1; }
    __device__ __forceinline__ void issue(f32x4 (&v)[8], int j, int, int lane) const { int e, k0, n0; coords(sid_of(j), lane, e, k0, n0);
        const float* sp = kargs()->in[I_W2] + (size_t)e * D * D + (unsigned)(k0 * D + n0);
#pragma unroll
        for (int r = 0; r < 8; ++r) v[r] = *(const f32x4*)(sp + r * D); }
    __device__ __forceinline__ void consume(const f32x4 (&v)[8], int j, int, int lane) const { int e, k0, n0; coords(sid_of(j), lane, e, k0, n0);
        unsigned char* dp = kargs()->ws + WS_W2T + (size_t)e * D * D + (unsigned)(n0 * D + k0);
#pragma unroll
        for (int c = 0; c < 4; ++c) { v2u o; o.x = pk_fp8x4(v[0][c] * W8_SCALE, v[1][c] * W8_SCALE, v[2][c] * W8_SCALE, v[3][c] * W8_SCALE); o.y = pk_fp8x4(v[4][c] * W8_SCALE, v[5][c] * W8_SCALE, v[6][c] * W8_SCALE, v[7][c] * W8_SCALE);
            *(v2u*)(dp + c * D) = o; } }
};
template <int E0, int NEXP> struct AuxW1 { static constexpr bool ON = true; static constexpr int TOTAL = NEXP * 4096; int gw, ngw, nsl;
    __device__ __forceinline__ int sid_of(int j) const { const int sid = gw + ngw * j; return sid < TOTAL ? sid : TOTAL - 1; }
    __device__ __forceinline__ void issue(f32x4 (&v)[8], int j, int, int lane) const { const int sid = sid_of(j), kb = (sid >> 7) & 31, nb = sid & 127, e = E0 + (sid >> 12);
        const float* sp = kargs()->in[I_W1] + (size_t)e * D * 4096 + (unsigned)((64 * kb + 8 * (lane >> 3)) * 4096 + 32 * nb + 4 * (lane & 7));
#pragma unroll
        for (int r = 0; r < 8; ++r) v[r] = *(const f32x4*)(sp + r * 4096); }
    __device__ __forceinline__ void consume(const f32x4 (&v)[8], int j, int, int lane) const { const int sid = sid_of(j), kb = (sid >> 7) & 31, nb = sid & 127, e = E0 + (sid >> 12);
        const int n0 = 32 * nb, hf = n0 >> 11, j0 = n0 & 2047, n0p = 256 * (j0 >> 7) + 16 * ((j0 & 127) >> 3) + 8 * hf, nq = lane & 7;
        unsigned char* dp = kargs()->ws + WS_W1T + ((size_t)e * 4096 + n0p + 16 * (nq >> 1) + 4 * (nq & 1)) * D + 64 * kb + 8 * (lane >> 3);
#pragma unroll
        for (int c = 0; c < 4; ++c) { v2u o; o.x = pk_fp8x4(v[0][c] * W8_SCALE, v[1][c] * W8_SCALE, v[2][c] * W8_SCALE, v[3][c] * W8_SCALE); o.y = pk_fp8x4(v[4][c] * W8_SCALE, v[5][c] * W8_SCALE, v[6][c] * W8_SCALE, v[7][c] * W8_SCALE);
            *(v2u*)(dp + (size_t)c * D) = o; } }
};

template <class Epi, class Sched, bool ALIGN_EPI, bool SP2, bool FP8, class Aux = AuxNone>
__device__ __forceinline__ int gemm_phase(LAS unsigned char* lds, const Sched& S, const Epi& E, int wave_, const Aux& X = Aux()) {
    const int wid = wave_, lane = lane_id(), tid = wid * 64 + lane, wr = wid >> 2, wc = wid & 3, fr = lane & 15, fq = lane >> 4;
    constexpr int nt = FP8 ? NT / 2 : NT;
    constexpr int ROWB = FP8 ? K : K * 2;
    unsigned voffB[2];
#pragma unroll
    for (int i = 0; i < 2; ++i) { int R, C; if constexpr (FP8) stage_rc8(tid * 16 + i * 8192, R, C); else { stage_rc(tid * 16 + i * 8192, R, C); C *= 2; }
        int Rb = R; if (Epi::PERM) { const int sp = (R & ~31) + perm32(R & 31); Rb = 16 * (sp >> 3) + (sp & 7); }
        voffB[i] = (unsigned)(Rb * ROWB + C); }
#define PG8_AOFF(unit, slot_, dst) do { const int tl_ = wid * 64 + lane_id(); int Ri_[2], Ci_[2]; _Pragma("unroll") for (int i_ = 0; i_ < 2; ++i_) { int R_, C_; \
        if constexpr (FP8) stage_rc8(tl_ * 16 + i_ * 8192, R_, C_); else { stage_rc(tl_ * 16 + i_ * 8192, R_, C_); C_ *= 2; } Ri_[i_] = R_; Ci_[i_] = C_; } S.a_off(unit, slot_, Ri_, Ci_, dst); } while (0)
    const size_t kstep = (size_t)(BK * 2);
    const size_t hstep = Epi::PERM ? (size_t)8 * ROWB : (size_t)HALF * ROWB;
    const unsigned ldsw = (unsigned)wid * 1024u;
    const int aoff = FP8 ? lds_byte8(wr * 64 + fr, fq * 32) : lds_byte(wr * 64 + fr, fq * 8), boff = FP8 ? lds_byte8(wc * 32 + fr, fq * 32) : lds_byte(wc * 32 + fr, fq * 8);
    const int aof2 = FP8 ? lds_byte8(wr * 64 + fr, fq * 32 + 16) : aoff + 1024, bof2 = FP8 ? lds_byte8(wc * 32 + fr, fq * 32 + 16) : boff + 1024;
#define PG8_SA(b, h) (((b) * 2 + (h)) * HTB)
#define PG8_SB(b, h) ((4 + (b) * 2 + (h)) * HTB)
#define PG8_STAGE(bufoff, gbase, voff) do { _Pragma("unroll") for (int _i = 0; _i < 2; ++_i) { asm volatile("" : "+v"((voff)[_i])); const unsigned vo_ = (voff)[_i];     \
        __builtin_amdgcn_global_load_lds((const unsigned*)((const char*)(gbase) + vo_), (LAS unsigned*)(lds + (bufoff) + ldsw + _i * 8192), 16, 0, 0); } } while (0)
#define PG8_LDA(dst, b, h) do { _Pragma("unroll") for (int m = 0; m < 4; ++m) { dst[m][0] = *(const LAS bf16x8*)(lds + PG8_SA(b, h) + aoff + m * 2048); dst[m][1] = *(const LAS bf16x8*)(lds + PG8_SA(b, h) + aof2 + m * 2048); } } while (0)
#define PG8_LDB(dst, b, h) do { _Pragma("unroll") for (int n = 0; n < 2; ++n) { dst[n][0] = *(const LAS bf16x8*)(lds + PG8_SB(b, h) + boff + n * 2048); dst[n][1] = *(const LAS bf16x8*)(lds + PG8_SB(b, h) + bof2 + n * 2048); } } while (0)
#define PG8_MMA(ai, bj, At, Bt) do { __builtin_amdgcn_s_setprio(1); _Pragma("unroll") for (int m = 0; m < 4; ++m) _Pragma("unroll") for (int n = 0; n < 2; ++n) { \
        if constexpr (FP8) { const v4i b0_ = __builtin_bit_cast(v4i, Bt[n][0]), b1_ = __builtin_bit_cast(v4i, Bt[n][1]), a0_ = __builtin_bit_cast(v4i, At[m][0]), a1_ = __builtin_bit_cast(v4i, At[m][1]); \
            acc[ai][bj][m][n] = __builtin_amdgcn_mfma_scale_f32_16x16x128_f8f6f4(__builtin_shufflevector(b0_, b1_, 0, 1, 2, 3, 4, 5, 6, 7), __builtin_shufflevector(a0_, a1_, 0, 1, 2, 3, 4, 5, 6, 7), acc[ai][bj][m][n], 0, 0, 0, 0x7f7f7f7f, 0, 0x7f7f7f7f); } \
        else { _Pragma("unroll") for (int k = 0; k < 2; ++k) acc[ai][bj][m][n] = __builtin_amdgcn_mfma_f32_16x16x32_bf16(Bt[n][k], At[m][k], acc[ai][bj][m][n], 0, 0, 0); } } \
        __builtin_amdgcn_s_setprio(0); } while (0)
#define PG8_WAIT_V(n) asm volatile("s_waitcnt vmcnt(" #n ")" ::: "memory")
#define PG8_WAIT_L(n) asm volatile("s_waitcnt lgkmcnt(" #n ")" ::: "memory")
#define PG8_BAR __builtin_amdgcn_s_barrier()
#define PG8_SCHED __builtin_amdgcn_sched_barrier(0)
    Unit cur, nxt; int ui = 0;
    if (!S.next(0, cur)) return 0;
    f32x4 acc[2][2][4][2];
#pragma unroll
    for (int a = 0; a < 2; ++a)
#pragma unroll
        for (int b = 0; b < 2; ++b)
#pragma unroll
            for (int m = 0; m < 4; ++m)
#pragma unroll
                for (int n = 0; n < 2; ++n) acc[a][b][m][n] = (f32x4){0.f, 0.f, 0.f, 0.f};
    bf16x8 At[4][2], B0[2][2], B1[2][2];
    const char* const Ab = S.a_base();
    const char* cB = S.b_ptr(cur);
    int slot = 0;
    S.tables(cur, 0, wid, lane);
    S.prep(cur, slot, tid); PG8_WAIT_L(0); PG8_BAR; asm volatile("" ::: "memory");
    unsigned ao[2][2];
    PG8_AOFF(cur, slot, ao);
    if constexpr (SP2) {
        PG8_STAGE(PG8_SB(0, 0), cB, voffB); PG8_STAGE(PG8_SB(0, 1), cB + hstep, voffB); PG8_STAGE(PG8_SA(0, 0), Ab, ao[0]); PG8_STAGE(PG8_SA(0, 1), Ab, ao[1]);
        if (wr == 1) PG8_BAR;
        PG8_WAIT_V(2); PG8_BAR;
        PG8_STAGE(PG8_SB(1, 0), cB + kstep, voffB); PG8_STAGE(PG8_SA(1, 0), Ab + kstep, ao[0]); PG8_STAGE(PG8_SB(1, 1), cB + hstep + kstep, voffB);
        PG8_WAIT_V(6); PG8_BAR;
    } else {
        PG8_STAGE(PG8_SB(0, 0), cB, voffB); PG8_STAGE(PG8_SA(0, 0), Ab, ao[0]); PG8_STAGE(PG8_SB(0, 1), cB + hstep, voffB); PG8_STAGE(PG8_SA(0, 1), Ab, ao[1]);
        if (wr == 1) PG8_BAR;
        PG8_WAIT_V(4); PG8_BAR;
        PG8_STAGE(PG8_SB(1, 0), cB + kstep, voffB); PG8_STAGE(PG8_SA(1, 0), Ab + kstep, ao[0]); PG8_STAGE(PG8_SB(1, 1), cB + hstep + kstep, voffB);
        PG8_WAIT_V(6); PG8_BAR;
    }
    for (;;) {
        const bool has_next = S.next(ui + 1, nxt);
        const char* nB = has_next ? S.b_ptr(nxt) : cB;
        if (ui > 0) S.tables(cur, ui & 1, wid, lane_id());
        if (has_next && S.need_prep(cur, nxt)) { slot ^= 1; S.prep(nxt, slot, wid * 64 + lane_id()); }
        for (int t = 0; t < nt; t += 2) {
            const bool last = (t == nt - 2);
            const char* a1 = Ab + (size_t)(t + 1) * kstep;
            const char* a2 = last ? Ab : Ab + (size_t)(t + 2) * kstep; const char* b2 = last ? nB : cB + (size_t)(t + 2) * kstep;
            const char* a3 = a2 + kstep; const char* b3 = b2 + kstep;
            if constexpr (SP2) {
            static_assert(SP2, "only the two-super-phase loop is kept");
            if constexpr (Epi::HAS_MID) { if (t == nt / 2) E.mid(acc, wr, lane_id() & 15, ui & 1); }
            unsigned ao1c[2] = {ao[1][0], ao[1][1]};
            if (last && has_next) PG8_AOFF(nxt, slot, ao);
            PG8_LDB(B0, 0, 0); PG8_LDB(B1, 0, 1); PG8_SCHED; PG8_LDA(At, 0, 0); PG8_STAGE(PG8_SA(1, 1), a1, ao1c);
            PG8_WAIT_V(8); PG8_WAIT_L(0); PG8_BAR; PG8_MMA(0, 0, At, B0); PG8_MMA(0, 1, At, B1); PG8_BAR; PG8_SCHED;
            PG8_LDA(At, 0, 1); PG8_STAGE(PG8_SB(0, 0), b2, voffB); PG8_STAGE(PG8_SB(0, 1), b2 + hstep, voffB); PG8_STAGE(PG8_SA(0, 0), a2, ao[0]);
            PG8_WAIT_V(8); PG8_WAIT_L(0); PG8_BAR; PG8_MMA(1, 0, At, B0); PG8_MMA(1, 1, At, B1); PG8_BAR; PG8_SCHED;
            PG8_LDB(B0, 1, 0); PG8_LDB(B1, 1, 1); PG8_SCHED; PG8_LDA(At, 1, 0); PG8_STAGE(PG8_SA(0, 1), a2, ao[1]);
            PG8_WAIT_V(8); PG8_WAIT_L(0); PG8_BAR; PG8_MMA(0, 0, At, B0); PG8_MMA(0, 1, At, B1); PG8_BAR; PG8_SCHED;
            PG8_LDA(At, 1, 1); PG8_STAGE(PG8_SB(1, 0), b3, voffB); PG8_STAGE(PG8_SB(1, 1), b3 + hstep, voffB); PG8_STAGE(PG8_SA(1, 0), a3, ao[0]);
            PG8_WAIT_V(8); PG8_WAIT_L(0); PG8_BAR; PG8_MMA(1, 0, At, B0); PG8_MMA(1, 1, At, B1); PG8_BAR; PG8_SCHED;
            }
        }
        if constexpr (ALIGN_EPI) { if (wr == 0) PG8_BAR; }
        if constexpr (Aux::ON) {
            f32x4 xv_[8];
            asm volatile("" ::: "memory"); PG8_SCHED;
            X.issue(xv_, ui < X.nsl ? ui : X.nsl - 1, wid, lane_id());
            asm volatile("" ::: "memory"); PG8_SCHED;
            { const int ln_ = lane_id(); E(acc, cur, wr, wc, ln_ & 15, ln_ >> 4, ui & 1); }
            asm volatile("" ::: "memory"); PG8_SCHED;
            X.consume(xv_, ui < X.nsl ? ui : X.nsl - 1, wid, lane_id());
        } else
        { const int ln_ = lane_id(); E(acc, cur, wr, wc, ln_ & 15, ln_ >> 4, ui & 1); }
        if (!has_next) break;
#pragma unroll
        for (int a = 0; a < 2; ++a)
#pragma unroll
            for (int b = 0; b < 2; ++b)
#pragma unroll
                for (int m = 0; m < 4; ++m)
#pragma unroll
                    for (int n = 0; n < 2; ++n) acc[a][b][m][n] = (f32x4){0.f, 0.f, 0.f, 0.f};
        cur = nxt; cB = nB; ++ui;
        if constexpr (ALIGN_EPI) { if (wr == 1) PG8_BAR; }
    }
    PG8_WAIT_V(0);
    if constexpr (!ALIGN_EPI) { if (wr == 0) PG8_BAR; }
    PG8_BAR;
    return ui + 1;
#undef PG8_AOFF
#undef PG8_SA
#undef PG8_SB
#undef PG8_STAGE
#undef PG8_LDA
#undef PG8_LDB
#undef PG8_MMA
#undef PG8_WAIT_V
#undef PG8_WAIT_L
#undef PG8_BAR
#undef PG8_SCHED
}
}

struct Frame {
    LAS unsigned char* lds;
    unsigned char* ws;
    int tid, lane, wave, G, blk, vblk;
};

__device__ __forceinline__ void phase0(Frame& F, const float* c, const float* w_ada) {
    LAS float* cond = (LAS float*)(F.lds);
    LAS float* red = (LAS float*)(F.lds + 4096);
    float* modp = (float*)(F.ws + WS_MODP);
    for (int item = F.blk; item < 256; item += F.G) {
        const int rg = item & 3, cg = item >> 2;
        for (int i = F.tid; i < 1024; i += NTHR) { const int b = i >> 9, d = i & 511; const float v = c[b * D + 512 * rg + d]; cond[i] = v / (1.0f + __expf(-v)); }
        __syncthreads();
        const int c4 = F.tid % 48, rl = F.tid / 48;
        if (rl < 10) {
            f32x4 a0 = {0.f, 0.f, 0.f, 0.f}, a1 = {0.f, 0.f, 0.f, 0.f};
            const float* wp = w_ada + (size_t)(512 * rg) * 12288 + 192 * cg + 4 * c4;
#pragma unroll 13
            for (int d = rl; d < 512; d += 10) { const f32x4 w = *(const f32x4*)(wp + (size_t)d * 12288); a0 += w * cond[d]; a1 += w * cond[512 + d]; }
            *(LAS f32x4*)(red + (rl * 2 + 0) * 192 + 4 * c4) = a0; *(LAS f32x4*)(red + (rl * 2 + 1) * 192 + 4 * c4) = a1;
        }
        __syncthreads();
        if (F.tid < 384) { const int b = F.tid / 192, col = F.tid % 192; float s = 0.f;
#pragma unroll
            for (int r = 0; r < 10; ++r) s += red[(r * 2 + b) * 192 + col];
            modp[(rg * 2 + b) * 12288 + 192 * cg + col] = s; }
        __syncthreads();
    }
}

__device__ __forceinline__ void tr_item(const float* src, int ld_src, bf16* dst, int ld_dst, const float* kscale, LAS unsigned* scr, int lane) {
    const int kq = lane >> 4, nq = lane & 15;
#pragma unroll 4
    for (int i = 0; i < 16; ++i) { const int k = 8 * i + 2 * kq;
        f32x4 v0 = *(const f32x4*)(src + (size_t)k * ld_src + 4 * nq), v1 = *(const f32x4*)(src + (size_t)(k + 1) * ld_src + 4 * nq);
        if (kscale) { v0 = v0 * kscale[k]; v1 = v1 * kscale[k + 1]; }
#pragma unroll
        for (int j = 0; j < 4; ++j) { const int n = 4 * nq + j; scr[n * 64 + 4 * (i ^ nq) + kq] = cvt_pk_bf16(v0[j], v1[j]); } }
    LDS_WAIT(); asm volatile("" ::: "memory");
#pragma unroll 4
    for (int jj = 0; jj < 16; ++jj) { const int id = jj * 64 + lane, n = id >> 4, c = id & 15;
        const v4u o = *(const LAS v4u*)(scr + n * 64 + 4 * (c ^ ((n >> 2) & 15)));
        *(v4u*)(dst + (size_t)n * ld_dst + 8 * c) = o; }
    LDS_WAIT(); asm volatile("" ::: "memory");
}

template <bool ILV> __device__ __forceinline__ void tr_item8(const float* src, int ld_src, unsigned char* dst, int ld_dst, float scale, LAS unsigned* scr, int lane) {
    const int kq = lane >> 3, nq = lane & 7;
#pragma unroll 8
    for (int i = 0; i < 8; ++i) { const int k = 32 * i + 4 * kq; const float* sp = src + (size_t)k * ld_src + 4 * nq;
        const f32x4 v0 = *(const f32x4*)sp * scale, v1 = *(const f32x4*)(sp + ld_src) * scale, v2 = *(const f32x4*)(sp + 2 * (size_t)ld_src) * scale, v3 = *(const f32x4*)(sp + 3 * (size_t)ld_src) * scale;
#pragma unroll
        for (int j = 0; j < 4; ++j) scr[(4 * nq + j) * 65 + 8 * i + kq] = pg8::pk_fp8x4(v0[j], v1[j], v2[j], v3[j]); }
    LDS_WAIT(); asm volatile("" ::: "memory");
#pragma unroll 4
    for (int jj = 0; jj < 8; ++jj) { const int id = jj * 64 + lane, n = id >> 4, c = id & 15; const LAS unsigned* p = scr + n * 65 + 4 * c;
        v4u o; o.x = p[0]; o.y = p[1]; o.z = p[2]; o.w = p[3];
        *(v4u*)(dst + (size_t)(ILV ? 16 * (n >> 3) + (n & 7) : n) * ld_dst + 16 * c) = o; }
    LDS_WAIT(); asm volatile("" ::: "memory");
}

__device__ __forceinline__ void phase1(Frame& F) {
    KArgs Ap = kargs(); struct { const float* in[23]; } A;
#pragma unroll
    for (int i = 0; i < 23; ++i) A.in[i] = Ap->in[i];
    const float* modp = (const float*)(F.ws + WS_MODP); float* mod = (float*)(F.ws + WS_MOD);
    const float* b_ada = A.in[I_BADA];
    for (int item = F.blk; item < 256; item += F.G) {
        if (F.tid < 96) { const int j = 96 * item + F.tid, b = j / 12288, jj = j % 12288; float s = b_ada[jj];
#pragma unroll
            for (int rg = 0; rg < 4; ++rg) s += modp[(rg * 2 + b) * 12288 + jj];
            mod[j] = s; }
    }
    LAS float* gs = (LAS float*)(F.lds + TAB_OFF); LAS float* sh = gs + D;
    bf16* H = (bf16*)(F.ws + WS_H); const float* x = A.in[I_X]; const float* mixg = A.in[I_MIXG];
    for (int item = F.blk; item < 256; item += F.G) {
        const int b = item >> 7;
        __syncthreads();
        for (int d = F.tid; d < D; d += NTHR) { float sc = b_ada[D + d], sf = b_ada[d];
#pragma unroll
            for (int rg = 0; rg < 4; ++rg) { sc += modp[(rg * 2 + b) * 12288 + D + d]; sf += modp[(rg * 2 + b) * 12288 + d]; }
            gs[d] = mixg[d] * (1.0f + sc); sh[d] = sf; }
        __syncthreads();
        f32x4 vn[4][2];
        { const float* xr = x + (size_t)(128 * item + 16 * F.wave) * D + 8 * F.lane;
#pragma unroll
          for (int j = 0; j < 4; ++j) { vn[j][0] = *(const f32x4*)(xr + 512 * j); vn[j][1] = *(const f32x4*)(xr + 512 * j + 4); } }
#pragma unroll 1
        for (int r = 0; r < 16; ++r) { const int row = 128 * item + 16 * F.wave + r;
            f32x4 v[4][2]; float ss = 0.f;
#pragma unroll
            for (int j = 0; j < 4; ++j) { v[j][0] = vn[j][0]; v[j][1] = vn[j][1]; }
            if (r < 15) { const float* xr = x + (size_t)(row + 1) * D + 8 * F.lane;
#pragma unroll
                for (int j = 0; j < 4; ++j) { vn[j][0] = *(const f32x4*)(xr + 512 * j); vn[j][1] = *(const f32x4*)(xr + 512 * j + 4); } }
#pragma unroll
            for (int j = 0; j < 4; ++j) {
                ss += (v[j][0][0] * v[j][0][0] + v[j][0][1] * v[j][0][1]) + (v[j][0][2] * v[j][0][2] + v[j][0][3] * v[j][0][3]) + (v[j][1][0] * v[j][1][0] + v[j][1][1] * v[j][1][1]) + (v[j][1][2] * v[j][1][2] + v[j][1][3] * v[j][1][3]); }
            const float rstd = 1.0f / sqrtf(wave_sum(ss) * (1.0f / D) + RMS_EPS);
#pragma unroll
            for (int j = 0; j < 4; ++j) { const int col = 8 * F.lane + 512 * j;
                const f32x4 g0 = *(const LAS f32x4*)(gs + col), g1 = *(const LAS f32x4*)(gs + col + 4), s0 = *(const LAS f32x4*)(sh + col), s1 = *(const LAS f32x4*)(sh + col + 4);
                const f32x4 o0 = v[j][0] * rstd * g0 + s0, o1 = v[j][1] * rstd * g1 + s1;
                v4u w; w.x = cvt_pk_bf16(o0[0], o0[1]); w.y = cvt_pk_bf16(o0[2], o0[3]); w.z = cvt_pk_bf16(o1[0], o1[1]); w.w = cvt_pk_bf16(o1[2], o1[3]);
                *(v4u*)(H + (size_t)row * D + col) = w; } }
    }
    { const float* gws = A.in[I_GWS]; unsigned* wsb = (unsigned*)(F.ws + WS_WSB);
      for (int p = F.blk * NTHR + F.tid; p < 8 * 128 * 64; p += F.G * NTHR) { const int j = (p & 63) * 2, i = (p >> 6) & 127;
          const bool keep = (i >> 6) >= (j >> 6); const float a = keep ? gws[2 * p] : 0.f, b = keep ? gws[2 * p + 1] : 0.f; wsb[p] = cvt_pk_bf16(a, b); } }
    { const float* rw = A.in[I_RW]; float* rwp = (float*)(F.ws + WS_RWP);
      for (int p = F.blk * NTHR + F.tid; p < D * NE; p += F.G * NTHR) { const int k = p & 3, ln = (p >> 2) & 63, c = (p >> 8) & 3, eh = (p >> 10) & 1, sI = (p >> 11) & 3, wI = p >> 13;
          rwp[p] = rw[(256 * wI + 64 * sI + 16 * (ln >> 4) + 4 * c + k) * NE + 16 * eh + (ln & 15)]; } }
    LAS unsigned* scr = (LAS unsigned*)(F.lds + RING_OFF + F.wave * 16384);
    const int gw = F.blk * NWAVES + F.wave, NGW = F.G * NWAVES;
    constexpr int I_IN = 16 * 48, I_OUT = 16 * 32, I_PW = 4 * 2 * 4;
    for (int it = gw; it < I_IN + I_OUT + I_PW; it += NGW) {
        int r = it;
        if (r < I_IN) { const int kb = r / 48, nb = r % 48;
            tr_item(A.in[I_WIN] + (size_t)(128 * kb) * ZW + 64 * nb, ZW, (bf16*)(F.ws + WS_WIN) + (size_t)(64 * nb) * D + 128 * kb, D, nullptr, scr, F.lane); continue; }
        r -= I_IN;
        if (r < I_OUT) { const int kb = r >> 5, nb = r & 31; const float* ks = (kb < 8) ? (A.in[I_GOUTG] + 128 * kb) : (A.in[I_POUTG] + 128 * (kb - 8));
            tr_item(A.in[I_WOUT] + (size_t)(128 * kb) * D + 64 * nb, D, (bf16*)(F.ws + WS_WOUT) + (size_t)(64 * nb) * D + 128 * kb, D, ks, scr, F.lane); continue; }
        r -= I_OUT;
        { const int g = r >> 3, kb = (r >> 2) & 1, nb = r & 3;
          tr_item(A.in[I_POOLW] + (size_t)g * 65536 + (size_t)(128 * kb) * 256 + 64 * nb, 256, (bf16*)(F.ws + WS_PWT) + (size_t)g * 65536 + (size_t)(64 * nb) * 256 + 128 * kb, 256, nullptr, scr, F.lane); }
    }
}

#ifndef CV_EXTRA
#define CV_EXTRA 5120
#endif
__device__ __forceinline__ void convert_item(const float* w1, const float* w2, unsigned char* ws, int r, LAS unsigned* scr, int lane) {
    constexpr int I_1 = 32 * 16 * 64;
    if (r < I_1) { const int e = r >> 10, kb = (r >> 7) & 7, nb = r & 127; const int n0 = 32 * nb, half = n0 >> 11, j0 = n0 & 2047, n0p = 256 * (j0 >> 7) + 16 * ((j0 & 127) >> 3) + 8 * half;
        tr_item8<true>(w1 + (size_t)e * D * 4096 + (size_t)(256 * kb) * 4096 + n0, 4096, ws + WS_W1T + ((size_t)e * 4096 + n0p) * D + 256 * kb, D, pg8::W8_SCALE, scr, lane); return; }
    r -= I_1;
    { const int e = r >> 9, kb = (r >> 6) & 7, nb = r & 63;
        tr_item8<false>(w2 + (size_t)e * D * D + (size_t)(256 * kb) * D + 32 * nb, D, ws + WS_W2T + ((size_t)e * D + 32 * nb) * D + 256 * kb, D, pg8::W8_SCALE, scr, lane); }
}
__device__ __forceinline__ void convert_big(Frame& F, bool first) {
    KArgs Ap = kargs(); const float* w1 = Ap->in[I_W1]; const float* w2 = Ap->in[I_W2];
    LAS unsigned* scr = (LAS unsigned*)(F.lds + RING_OFF + F.wave * 16384);
    constexpr int N_ALL = 21 * 16 * 64, N_X = CV_EXTRA;
    if (first) { const int gt = (F.vblk >> 1) * NWAVES + F.wave, NGT = ((F.G + 1) >> 1) * NWAVES;
        for (int it = gt; it < N_X; it += NGT) convert_item(w1, w2, F.ws, it, scr, F.lane); }
    const int gw = F.vblk * NWAVES + F.wave, NGW = F.G * NWAVES;
    for (int it = N_X + gw; it < N_ALL; it += NGW) convert_item(w1, w2, F.ws, it, scr, F.lane);
}

__device__ __forceinline__ int vsw(int d) { return (d & 15) ^ ((d >> 4) & 7); }
__device__ __forceinline__ f32x4 bf4(v2u r) { return (f32x4){bf_lo(r.x), bf_hi(r.x), bf_lo(r.y), bf_hi(r.y)}; }
__device__ __forceinline__ void pool_stage(const bf16* Z, int t0, int tpos0, int g, int rq  , int c4  , LAS unsigned* poolA) {
    const int win = 2 << g;
    const bf16* zu = Z + (size_t)t0 * ZW + 2048 + 256 * g;
    v2u raw[32];
#pragma unroll
    for (int k = 0; k < 32; ++k) { const int t = 16 * rq - 16 + k; const int tc = (tpos0 + t >= 0) ? t : 0; raw[k] = *(const v2u*)(zu + (long)tc * ZW + 4 * c4); if (tpos0 + t < 0) raw[k] = (v2u){0u, 0u}; }
    f32x4 S = {0.f, 0.f, 0.f, 0.f};
#pragma unroll
    for (int k = 0; k < 16; ++k) { const f32x4 p = bf4(raw[k]); if (k >= 16 - win) S += p; }
#pragma unroll
    for (int j = 0; j < 16; ++j) { const int t = 16 * rq + j;
        const f32x4 p = bf4(raw[16 + j]);
        const v2u qr = (win == 2) ? raw[14 + j] : (win == 4) ? raw[12 + j] : (win == 8) ? raw[8 + j] : raw[j];
        S = S + p - bf4(qr);
        const int cn = (tpos0 + t + 1) < win ? (tpos0 + t + 1) : win; const float ic = 1.0f / (float)cn;
        const f32x4 o = S * ic - p;
        v2u w; w.x = cvt_pk_bf16(o[0], o[1]); w.y = cvt_pk_bf16(o[2], o[3]);
        *(LAS v2u*)(poolA + t * 128 + 4 * ((c4 >> 1) ^ (t & 15)) + 2 * (c4 & 1)) = w; }
}
__device__ __forceinline__ void phase3(Frame& F) {
    KArgs Ap = kargs(); struct { const float* in[23]; } A;
    A.in[I_LNG] = Ap->in[I_LNG]; A.in[I_LNB] = Ap->in[I_LNB]; A.in[I_GBS] = Ap->in[I_GBS]; A.in[I_POOLS] = Ap->in[I_POOLS];
    const float* pscale = A.in[I_POOLS];
    LAS float* lngT = (LAS float*)(F.lds + 65536); LAS float* lnbT = lngT + 1024; LAS float* gbsT = lngT + 2048;
    LAS float* ssaT = (LAS float*)(F.lds + TAB_OFF);
    LAS float* ssbT = (LAS float*)(F.lds + TAB_OFF + 2048);
    LAS float* rab = (LAS float*)(F.lds + TAB_OFF + 6144);
    const int w = F.wave;
    for (int item = F.blk; item < 256; item += F.G) {
        const int lane = lane_id(), tid = w * 64 + lane, fr = lane & 15, fq = lane >> 4;
        const int t0 = 128 * item, tpos0 = t0 & (SEQ - 1);
        unsigned char* wsp = kargs()->ws;
        const bf16* Z = (const bf16*)(wsp + WS_Z); bf16* MIX = (bf16*)(wsp + WS_MIX); const bf16* WSB = (const bf16*)(wsp + WS_WSB); const bf16* PWT = (const bf16*)(wsp + WS_PWT);
        const int wi = w >> 2, wd = w & 3;
        float ssq[4] = {0.f, 0.f, 0.f, 0.f};
        const int li = tid >> 3, cg = tid & 7;
        v4u pre[4];
        { const bf16* zp = Z + (size_t)(t0 + 2 * li) * ZW + 1024 + 16 * cg; pre[0] = *(const v4u*)zp; pre[1] = *(const v4u*)(zp + 8); pre[2] = *(const v4u*)(zp + ZW); pre[3] = *(const v4u*)(zp + ZW + 8); }
        { KArgs ap_ = kargs(); const float* lng_ = ap_->in[I_LNG]; const float* lnb_ = ap_->in[I_LNB]; const float* gbs_ = ap_->in[I_GBS];
          for (int d = tid; d < 1024; d += NTHR) { lngT[d] = lng_[d]; lnbT[d] = lnb_[d]; gbsT[d] = gbs_[d]; } }
        LDS_WAIT(); __syncthreads();
#pragma unroll 1
        for (int h = 0; h < 8; ++h) {
            LAS unsigned* vnT = (LAS unsigned*)(F.lds + (h & 1) * 32768);
            f32x4 sv[8];
            { const int sid = (item * 8 + w) * 8 + h, kb = (sid >> 7) & 31, nb = sid & 127, e = 24 + (sid >> 12);
              const float* sp = kargs()->in[I_W1] + (size_t)e * D * 4096 + (unsigned)((64 * kb + 8 * (lane >> 3)) * 4096 + 32 * nb + 4 * (lane & 7));
#pragma unroll
              for (int rr = 0; rr < 8; ++rr) sv[rr] = *(const f32x4*)(sp + rr * 4096); }
            bf16x8 afr[4][4]; v4u uw[4];
            {
                float x0[16], x1[16];
#pragma unroll
                for (int k = 0; k < 4; ++k) { x0[2 * k] = bf_lo(pre[0][k]); x0[2 * k + 1] = bf_hi(pre[0][k]); x0[8 + 2 * k] = bf_lo(pre[1][k]); x0[8 + 2 * k + 1] = bf_hi(pre[1][k]);
                                              x1[2 * k] = bf_lo(pre[2][k]); x1[2 * k + 1] = bf_hi(pre[2][k]); x1[8 + 2 * k] = bf_lo(pre[3][k]); x1[8 + 2 * k + 1] = bf_hi(pre[3][k]); }
                if (h < 7) { const bf16* zp = Z + (size_t)(t0 + 2 * li) * ZW + 1024 + 128 * (h + 1) + 16 * cg; pre[0] = *(const v4u*)zp; pre[1] = *(const v4u*)(zp + 8); pre[2] = *(const v4u*)(zp + ZW); pre[3] = *(const v4u*)(zp + ZW + 8); }
                float s0 = 0.f, s1 = 0.f;
#pragma unroll
                for (int k = 0; k < 16; ++k) { s0 += x0[k]; s1 += x1[k]; }
                s0 += __shfl_xor(s0, 1); s0 += __shfl_xor(s0, 2); s0 += __shfl_xor(s0, 4); s1 += __shfl_xor(s1, 1); s1 += __shfl_xor(s1, 2); s1 += __shfl_xor(s1, 4);
                const float m0 = s0 * (1.0f / 128.0f), m1 = s1 * (1.0f / 128.0f); float q0 = 0.f, q1 = 0.f;
#pragma unroll
                for (int k = 0; k < 16; ++k) { x0[k] -= m0; x1[k] -= m1; q0 += x0[k] * x0[k]; q1 += x1[k] * x1[k]; }
                q0 += __shfl_xor(q0, 1); q0 += __shfl_xor(q0, 2); q0 += __shfl_xor(q0, 4); q1 += __shfl_xor(q1, 1); q1 += __shfl_xor(q1, 2); q1 += __shfl_xor(q1, 4);
                const float r0 = 1.0f / sqrtf(q0 * (1.0f / 128.0f) + LN_EPS), r1 = 1.0f / sqrtf(q1 * (1.0f / 128.0f) + LN_EPS);
                const LAS float* gp = lngT + 128 * h + 16 * cg; const LAS float* bp = lnbT + 128 * h + 16 * cg;
#pragma unroll
                for (int k4 = 0; k4 < 4; ++k4) { const f32x4 g4 = *(const LAS f32x4*)(gp + 4 * k4), b4 = *(const LAS f32x4*)(bp + 4 * k4);
#pragma unroll
                    for (int k = 0; k < 4; ++k) { const int cc = 4 * k4 + k, ch = 16 * cg + cc;
                        const float y0 = x0[cc] * r0 * g4[k] + b4[k], y1 = x1[cc] * r1 * g4[k] + b4[k];
                        vnT[ch * 64 + 4 * ((li >> 2) ^ vsw(ch)) + (li & 3)] = cvt_pk_bf16(y0, y1); } }
            }
            LDS_WAIT(); __syncthreads();
            {
#pragma unroll
                for (int s = 0; s < 4; ++s) uw[s] = *(const v4u*)(Z + (size_t)(t0 + 64 * wi + 16 * s + fr) * ZW + 128 * h + 32 * wd + 8 * fq);
#pragma unroll
                for (int s = 0; s < 4; ++s)
#pragma unroll
                    for (int ks = 0; ks < 4; ++ks) afr[s][ks] = *(const bf16x8*)(WSB + ((size_t)(h * 128 + 64 * wi + 16 * s + fr) * 128 + 32 * ks + 8 * fq));
                bf16x8 bfr[2][4];
#pragma unroll
                for (int t2 = 0; t2 < 2; ++t2)
#pragma unroll
                    for (int ks = 0; ks < 4; ++ks) { const int d = 32 * wd + 8 * (fr >> 2) + 4 * t2 + (fr & 3); bfr[t2][ks] = *(const LAS bf16x8*)(vnT + d * 64 + 4 * ((4 * ks + fq) ^ vsw(d))); }
#pragma unroll
                for (int s = 0; s < 4; ++s) { const int irow = 64 * wi + 16 * s + fr;
                    f32x4 acc[2] = {{0.f, 0.f, 0.f, 0.f}, {0.f, 0.f, 0.f, 0.f}};
#pragma unroll
                    for (int ks = 0; ks < 4; ++ks)
#pragma unroll
                        for (int t2 = 0; t2 < 2; ++t2) acc[t2] = __builtin_amdgcn_mfma_f32_16x16x32_bf16(bfr[t2][ks], afr[s][ks], acc[t2], 0, 0, 0);
                    const float bsv = gbsT[h * 128 + irow];
                    v4u o4;
#pragma unroll
                    for (int t2 = 0; t2 < 2; ++t2) { const unsigned ux = t2 ? uw[s].z : uw[s].x, uy = t2 ? uw[s].w : uw[s].y;
                        const float a0 = bf_lo(ux) * (acc[t2][0] + bsv), a1 = bf_hi(ux) * (acc[t2][1] + bsv), a2 = bf_lo(uy) * (acc[t2][2] + bsv), a3 = bf_hi(uy) * (acc[t2][3] + bsv);
                        ssq[s] += (a0 * a0 + a1 * a1) + (a2 * a2 + a3 * a3);
                        if (t2) { o4.z = cvt_pk_bf16(a0, a1); o4.w = cvt_pk_bf16(a2, a3); } else { o4.x = cvt_pk_bf16(a0, a1); o4.y = cvt_pk_bf16(a2, a3); } }
                    *(v4u*)(MIX + (size_t)(t0 + irow) * D + 128 * h + 32 * wd + 8 * fq) = o4; }
            }
            { const int sid = (item * 8 + w) * 8 + h, kb = (sid >> 7) & 31, nb = sid & 127, e = 24 + (sid >> 12);
              const int n0 = 32 * nb, hf = n0 >> 11, j0 = n0 & 2047, n0p = 256 * (j0 >> 7) + 16 * ((j0 & 127) >> 3) + 8 * hf, nq = lane & 7;
              unsigned char* dp = F.ws + WS_W1T + ((size_t)e * 4096 + n0p + 16 * (nq >> 1) + 4 * (nq & 1)) * D + 64 * kb + 8 * (lane >> 3);
#pragma unroll
              for (int c = 0; c < 4; ++c) { v2u o; o.x = pg8::pk_fp8x4(sv[0][c] * pg8::W8_SCALE, sv[1][c] * pg8::W8_SCALE, sv[2][c] * pg8::W8_SCALE, sv[3][c] * pg8::W8_SCALE);
                  o.y = pg8::pk_fp8x4(sv[4][c] * pg8::W8_SCALE, sv[5][c] * pg8::W8_SCALE, sv[6][c] * pg8::W8_SCALE, sv[7][c] * pg8::W8_SCALE); *(v2u*)(dp + (size_t)c * D) = o; } }
        }
#pragma unroll
        for (int s = 0; s < 4; ++s) { float v = ssq[s]; v += __shfl_xor(v, 16); v += __shfl_xor(v, 32); if (fq == 0) ssaT[(64 * wi + 16 * s + fr) * 4 + wd] = v; }
        __syncthreads();
        float ssb[8] = {0.f, 0.f, 0.f, 0.f, 0.f, 0.f, 0.f, 0.f};
#pragma unroll 1
        for (int g = 0; g < 4; ++g) {
            LAS unsigned* poolA = (LAS unsigned*)(F.lds + (g & 1) * 65536);
            pool_stage(Z, t0, tpos0, g, w, lane, poolA);
            LDS_WAIT(); __syncthreads();
            {
                f32x4 acc[8][2];
#pragma unroll
                for (int s = 0; s < 8; ++s) { acc[s][0] = (f32x4){0.f, 0.f, 0.f, 0.f}; acc[s][1] = (f32x4){0.f, 0.f, 0.f, 0.f}; }
#pragma unroll 2
                for (int ks = 0; ks < 8; ++ks) {
                    bf16x8 bfr[2];
#pragma unroll
                    for (int t2 = 0; t2 < 2; ++t2) bfr[t2] = *(const bf16x8*)(PWT + ((size_t)(g * 256 + 32 * w + 8 * (fr >> 2) + 4 * t2 + (fr & 3)) * 256 + 32 * ks + 8 * fq));
#pragma unroll
                    for (int s = 0; s < 8; ++s) { const int t = 16 * s + fr; const bf16x8 afr = *(const LAS bf16x8*)(poolA + t * 128 + 4 * ((4 * ks + fq) ^ (t & 15)));
                        acc[s][0] = __builtin_amdgcn_mfma_f32_16x16x32_bf16(bfr[0], afr, acc[s][0], 0, 0, 0); acc[s][1] = __builtin_amdgcn_mfma_f32_16x16x32_bf16(bfr[1], afr, acc[s][1], 0, 0, 0); }
                }
                { const int dg = 256 * g + 32 * w + 8 * fq; const f32x4 ps0 = *(const f32x4*)(pscale + dg), ps1 = *(const f32x4*)(pscale + dg + 4);
#pragma unroll
                    for (int s = 0; s < 8; ++s) { const int t = 16 * s + fr; const f32x4 y0 = acc[s][0] * ps0, y1 = acc[s][1] * ps1;
                        ssb[s] += ((y0[0] * y0[0] + y0[1] * y0[1]) + (y0[2] * y0[2] + y0[3] * y0[3])) + ((y1[0] * y1[0] + y1[1] * y1[1]) + (y1[2] * y1[2] + y1[3] * y1[3]));
                        v4u o; o.x = cvt_pk_bf16(y0[0], y0[1]); o.y = cvt_pk_bf16(y0[2], y0[3]); o.z = cvt_pk_bf16(y1[0], y1[1]); o.w = cvt_pk_bf16(y1[2], y1[3]); *(v4u*)(MIX + (size_t)(t0 + t) * D + 1024 + dg) = o; } }
            }
        }
#pragma unroll
        for (int s = 0; s < 8; ++s) { float v = ssb[s]; v += __shfl_xor(v, 16); v += __shfl_xor(v, 32); if (fq == 0) ssbT[(16 * s + fr) * 8 + w] = v; }
        LDS_WAIT(); __syncthreads();
        if (tid < 128) { float sa = 0.f, sb = 0.f;
#pragma unroll
            for (int k = 0; k < 4; ++k) sa += ssaT[tid * 4 + k];
#pragma unroll
            for (int k = 0; k < 8; ++k) sb += ssbT[tid * 8 + k];
            ((float*)(F.ws + WS_RA))[t0 + tid] = 1.0f / sqrtf(sa * (1.0f / 1024.0f) + RMS_EPS); ((float*)(F.ws + WS_RB))[t0 + tid] = 1.0f / sqrtf(sb * (1.0f / 1024.0f) + RMS_EPS); }
        __syncthreads();
    }
}

__device__ __forceinline__ void phase5(Frame& F) {
    KArgs Ap = kargs(); struct { const float* in[23]; } A;
    A.in[I_RW] = Ap->in[I_RW]; A.in[I_RB] = Ap->in[I_RB]; A.in[I_FFNG] = Ap->in[I_FFNG];
    const float* w1 = Ap->in[I_W1];
    const float* mod = (const float*)(F.ws + WS_MOD); const bf16* X1 = (const bf16*)(F.ws + WS_X1); unsigned char* H2 = (unsigned char*)(F.ws + WS_H8);
    const float* rwp = (const float*)(F.ws + WS_RWP); const float* rb = A.in[I_RB]; const float* ffng = A.in[I_FFNG];
    float* lgate = (float*)(F.ws + WS_LGATE); int* list = (int*)(F.ws + WS_LIST); unsigned* cnt = (unsigned*)(F.ws + WS_CTL) + CW_CNT;
    LAS float* gsf = (LAS float*)(F.lds + TAB_OFF); LAS float* shf = gsf + D;
    LAS float* part = (LAS float*)(F.lds);
    LAS float* ssp = (LAS float*)(F.lds + 32768);
    LAS int* lcnt = (LAS int*)(F.lds + 32768 + 1024 + 2048);
    LAS int* gbase = lcnt + 32;
    LAS int* ebuf = gbase + 32;
    LAS int* lpos = ebuf + 512;
    LAS float* gbuf = (LAS float*)(lpos + 512);
    const int tid = F.tid, lane = F.lane, w = F.wave, r = lane & 15, q = lane >> 4;
    for (int item = F.blk; item < 256; item += F.G) {
        const int t0 = 128 * item, b = item >> 7;
        __syncthreads();
        for (int d = tid; d < D; d += NTHR) { gsf[d] = ffng[d] * (1.0f + mod[b * 12288 + 4 * D + d]); shf[d] = mod[b * 12288 + 3 * D + d]; }
        if (tid < 32) lcnt[tid] = 0;
        __syncthreads();
        v4u xr[4][2];
        { const bf16* xp = X1 + (size_t)(t0 + r) * D + 256 * w + 16 * q;
#pragma unroll
          for (int s = 0; s < 4; ++s) { xr[s][0] = *(const v4u*)(xp + 64 * s); xr[s][1] = *(const v4u*)(xp + 64 * s + 8); } }
        f32x4 xv[4][4];
#define P5_UNPACK(buf) do { float ss_ = 0.f; _Pragma("unroll") for (int s = 0; s < 4; ++s) _Pragma("unroll") for (int hh = 0; hh < 2; ++hh) { const v4u x = xr[s][hh]; \
            xv[s][2 * hh] = (f32x4){bf_lo(x.x), bf_hi(x.x), bf_lo(x.y), bf_hi(x.y)}; xv[s][2 * hh + 1] = (f32x4){bf_lo(x.z), bf_hi(x.z), bf_lo(x.w), bf_hi(x.w)}; \
            const f32x4 p0 = xv[s][2 * hh], p1 = xv[s][2 * hh + 1]; \
            ss_ += (p0[0] * p0[0] + p0[1] * p0[1]) + (p0[2] * p0[2] + p0[3] * p0[3]) + (p1[0] * p1[0] + p1[1] * p1[1]) + (p1[2] * p1[2] + p1[3] * p1[3]); } \
            ss_ += __shfl_xor(ss_, 16); ss_ += __shfl_xor(ss_, 32); if (q == 0) ssp[(buf) * 128 + w * 16 + r] = ss_; } while (0)
#define P5_LOADX(tokrow) do { const bf16* xp = X1 + (size_t)(tokrow) * D + 256 * w + 16 * q; _Pragma("unroll") for (int s = 0; s < 4; ++s) { xr[s][0] = *(const v4u*)(xp + 64 * s); xr[s][1] = *(const v4u*)(xp + 64 * s + 8); } } while (0)
        P5_UNPACK(0);
        P5_LOADX(t0 + 16 + r);
        LDS_WAIT(); __syncthreads();
#pragma unroll 1
        for (int grp = 0; grp < 8; ++grp) {
            const int tok = t0 + 16 * grp + r, par = grp & 1;
            f32x4 sv[8];
            { const int sid = (item * 8 + w) * 8 + grp, kb = (sid >> 7) & 31, nb = sid & 127, e = 28 + (sid >> 12);
              const float* sp = w1 + (size_t)e * D * 4096 + (unsigned)((64 * kb + 8 * (lane >> 3)) * 4096 + 32 * nb + 4 * (lane & 7));
#pragma unroll
              for (int rr = 0; rr < 8; ++rr) sv[rr] = *(const f32x4*)(sp + rr * 4096); }
            float tot = 0.f;
#pragma unroll
            for (int k = 0; k < 8; ++k) tot += ssp[par * 128 + k * 16 + r];
            const float rstd = 1.0f / sqrtf(tot * (1.0f / D) + RMS_EPS);
            unsigned char* hp = H2 + (size_t)tok * D + 256 * w + 16 * q;
#pragma unroll
            for (int s = 0; s < 4; ++s) { const int col = 256 * w + 64 * s + 16 * q; v4u o;
#pragma unroll
                for (int c = 0; c < 4; ++c) { const f32x4 g = *(const LAS f32x4*)(gsf + col + 4 * c), sh4 = *(const LAS f32x4*)(shf + col + 4 * c);
                    xv[s][c] = xv[s][c] * rstd * g + sh4; const unsigned pk = pg8::pk_fp8x4(xv[s][c][0], xv[s][c][1], xv[s][c][2], xv[s][c][3]);
                    if (c == 0) o.x = pk; else if (c == 1) o.y = pk; else if (c == 2) o.z = pk; else o.w = pk; }
                *(v4u*)(hp + 64 * s) = o; }
            f32x4 acc0 = {0.f, 0.f, 0.f, 0.f}, acc1 = {0.f, 0.f, 0.f, 0.f};
            int rwo = w * 8192 + lane * 4; asm volatile("" : "+v"(rwo));
#pragma unroll
            for (int s = 0; s < 4; ++s) {
#pragma unroll
                for (int c = 0; c < 4; ++c) { const f32x4 b0 = *(const f32x4*)(rwp + rwo + (s * 2 + 0) * 1024 + 256 * c), b1 = *(const f32x4*)(rwp + rwo + (s * 2 + 1) * 1024 + 256 * c);
#pragma unroll
                    for (int k = 0; k < 4; ++k) { const float a = xv[s][c][k];
                        acc0 = __builtin_amdgcn_mfma_f32_16x16x4f32(a, b0[k], acc0, 0, 0, 0); acc1 = __builtin_amdgcn_mfma_f32_16x16x4f32(a, b1[k], acc1, 0, 0, 0); } } }
#pragma unroll
            for (int k = 0; k < 4; ++k) { part[par * 4096 + (w * 16 + 4 * q + k) * 32 + r] = acc0[k]; part[par * 4096 + (w * 16 + 4 * q + k) * 32 + 16 + r] = acc1[k]; }
            if (grp < 7) { P5_UNPACK(par ^ 1); if (grp < 6) P5_LOADX(tok + 32); }
            { const int sid = (item * 8 + w) * 8 + grp, kb = (sid >> 7) & 31, nb = sid & 127, e = 28 + (sid >> 12);
              const int n0 = 32 * nb, hf = n0 >> 11, j0 = n0 & 2047, n0p = 256 * (j0 >> 7) + 16 * ((j0 & 127) >> 3) + 8 * hf, nq = lane & 7;
              unsigned char* dp = F.ws + WS_W1T + ((size_t)e * 4096 + n0p + 16 * (nq >> 1) + 4 * (nq & 1)) * D + 64 * kb + 8 * (lane >> 3);
#pragma unroll
              for (int c = 0; c < 4; ++c) { v2u o; o.x = pg8::pk_fp8x4(sv[0][c] * pg8::W8_SCALE, sv[1][c] * pg8::W8_SCALE, sv[2][c] * pg8::W8_SCALE, sv[3][c] * pg8::W8_SCALE);
                  o.y = pg8::pk_fp8x4(sv[4][c] * pg8::W8_SCALE, sv[5][c] * pg8::W8_SCALE, sv[6][c] * pg8::W8_SCALE, sv[7][c] * pg8::W8_SCALE); *(v2u*)(dp + (size_t)c * D) = o; } }
            LDS_WAIT(); __syncthreads();
            {
              const int tk = tid >> 5, e = tid & 31; float lg = rb[e];
#pragma unroll
              for (int k = 0; k < 8; ++k) lg += part[par * 4096 + (k * 16 + tk) * 32 + e];
              float val[4]; int idx[4]; float v = lg;
#pragma unroll
              for (int k = 0; k < 4; ++k) { float m = v; int mi = e;
#pragma unroll
                  for (int off = 16; off >= 1; off >>= 1) { const float om = __shfl_xor(m, off); const int oi = __shfl_xor(mi, off); if (om > m || (om == m && oi < mi)) { m = om; mi = oi; } }
                  val[k] = m; idx[k] = mi; if (e == mi) v = -3.0e38f; }
              float ex[4], sum = 0.f;
#pragma unroll
              for (int k = 0; k < 4; ++k) { ex[k] = __expf(val[k] - val[0]); sum += ex[k]; }
              const float inv = 1.0f / sum;
              if (e < 4) { const float gk = (e == 0 ? ex[0] : e == 1 ? ex[1] : e == 2 ? ex[2] : ex[3]) * inv; const int ik = e == 0 ? idx[0] : e == 1 ? idx[1] : e == 2 ? idx[2] : idx[3];
                  const int a = (16 * grp + tk) * 4 + e; gbuf[a] = gk; ebuf[a] = ik; lpos[a] = __hip_atomic_fetch_add(&lcnt[ik], 1, __ATOMIC_RELAXED, __HIP_MEMORY_SCOPE_WORKGROUP); } }
        }
#undef P5_UNPACK
#undef P5_LOADX
        LDS_WAIT(); __syncthreads();
        if (tid < 32) gbase[tid] = (int)__hip_atomic_fetch_add(cnt + 64 * tid, (unsigned)lcnt[tid], __ATOMIC_RELAXED, __HIP_MEMORY_SCOPE_AGENT);
        LDS_WAIT(); __syncthreads();
        { const int e = ebuf[tid]; const size_t li = (size_t)e * LCAP + gbase[e] + lpos[tid]; list[li] = t0 * 4 + tid; lgate[li] = gbuf[tid]; }
    }
}

__device__ __forceinline__ void phase8(Frame& F) {
    KArgs Ap = kargs(); struct { const float* in[23]; float* out; } A;
    A.in[I_FING] = Ap->in[I_FING]; A.out = Ap->out;
    const float* mod = (const float*)(F.ws + WS_MOD); const bf16* X1 = (const bf16*)(F.ws + WS_X1); const unsigned char* Y4 = F.ws + WS_Y4;
    const float* fing = A.in[I_FING]; float* out = A.out;
    LAS float* gfb = (LAS float*)(F.lds); LAS float* fg = gfb + 2 * D;
    __syncthreads();
    for (int d = F.tid; d < 2 * D; d += NTHR) gfb[d] = mod[(d >> 11) * 12288 + 5 * D + (d & (D - 1))] * pg8::Y8_INV;
    for (int d = F.tid; d < D; d += NTHR) fg[d] = fing[d];
    __syncthreads();
    const int gw = F.blk * NWAVES + F.wave, NGW = F.G * NWAVES;
#pragma unroll 1
    for (int tok = gw; tok < T; tok += NGW) { const LAS float* gf = gfb + (tok >= SEQ ? D : 0);
            f32x4 v[2][4]; float ss = 0.f;
            v4u yw[2][4];
#pragma unroll
            for (int j = 0; j < 2; ++j)
#pragma unroll
                for (int k = 0; k < 4; ++k) yw[j][k] = *(const v4u*)(Y4 + ((size_t)tok * 4 + k) * D + 16 * F.lane + 1024 * j);
#pragma unroll
            for (int j = 0; j < 2; ++j)
#pragma unroll
                for (int c2 = 0; c2 < 2; ++c2) { const v4u xw = *(const v4u*)(X1 + (size_t)tok * D + 16 * F.lane + 1024 * j + 8 * c2);
                    v[j][2 * c2] = (f32x4){bf_lo(xw.x), bf_hi(xw.x), bf_lo(xw.y), bf_hi(xw.y)}; v[j][2 * c2 + 1] = (f32x4){bf_lo(xw.z), bf_hi(xw.z), bf_lo(xw.w), bf_hi(xw.w)}; }
#pragma unroll
            for (int j = 0; j < 2; ++j)
#pragma unroll
                for (int c = 0; c < 4; ++c) { f32x4 y = {0.f, 0.f, 0.f, 0.f};
#pragma unroll
                    for (int k = 0; k < 4; ++k) { const f32x2 lo = __builtin_amdgcn_cvt_pk_f32_fp8((int)yw[j][k][c], false), hi = __builtin_amdgcn_cvt_pk_f32_fp8((int)yw[j][k][c], true); y += (f32x4){lo.x, lo.y, hi.x, hi.y}; }
                    const f32x4 g = *(const LAS f32x4*)(gf + 16 * F.lane + 1024 * j + 4 * c);
                    v[j][c] = v[j][c] + g * y;
                    ss += (v[j][c][0] * v[j][c][0] + v[j][c][1] * v[j][c][1]) + (v[j][c][2] * v[j][c][2] + v[j][c][3] * v[j][c][3]); }
            const float rstd = 1.0f / sqrtf(wave_sum(ss) * (1.0f / D) + RMS_EPS);
#pragma unroll
            for (int j = 0; j < 2; ++j)
#pragma unroll
                for (int c = 0; c < 4; ++c) { const int col = 16 * F.lane + 1024 * j + 4 * c;
                    *(f32x4*)(out + (size_t)tok * D + col) = v[j][c] * rstd * *(const LAS f32x4*)(fg + col); } }
}

__global__ void __launch_bounds__(NTHR, 2) mk_fwd(Args args) {
    extern __shared__ __attribute__((aligned(16))) unsigned char lds_raw[];
    Frame F;
    F.lds = (LAS unsigned char*)lds_raw; F.ws = args.ws;
    F.wave = __builtin_amdgcn_readfirstlane((int)threadIdx.x >> 6); F.G = gridDim.x; F.blk = blockIdx.x; F.vblk = F.blk;
#define REFRESH() do { F.lane = lane_id(); F.tid = F.wave * 64 + F.lane; } while (0)
    REFRESH();
    volatile LAS unsigned* MISC = (volatile LAS unsigned*)(F.lds + MISC_OFF);
    if (F.tid < 32) MISC[F.tid] = 0u;
    __syncthreads();
    unsigned* ctl = (unsigned*)(F.ws + WS_CTL);
#if MK_PER_PHASE
#define GRID_BAR() do { } while (0)
#else
    XcdBarrier bar = xcd_barrier_post(ctl + CW_BAR, MISC + 8, F.tid == 0);
#define GRID_BAR() xcd_barrier(bar, F.wave == 0 && lane_id() == 0)
#endif
    const int lo = args.ph_lo, hi = args.ph_hi;
#ifndef PH_MASK
#define PH_MASK 0x1ff
#endif
#define IN(k) (((PH_MASK >> (k)) & 1) && lo <= (k) && (k) < hi)
#define BOTH(k) (IN(k) && IN((k) + 1))
#ifndef REP_MASK
#define REP_MASK 0
#endif
#define REP(k) ((REP_MASK >> (k)) & 1)

    if (IN(0)) { REFRESH(); KArgs Ap = kargs(); phase0(F, Ap->in[I_C], Ap->in[I_WADA]); if (BOTH(0)) GRID_BAR(); if (REP(0)) { phase0(F, Ap->in[I_C], Ap->in[I_WADA]); GRID_BAR(); } }
#if !MK_PER_PHASE
    if (BOTH(0)) { if (F.wave == 0 && lane_id() == 0) { bool even = (F.G % 8) == 0; for (unsigned j = 0; j < 8; ++j) even = even && (xb_ld(&bar.bar[XB_XCNT(j)]) == (unsigned)F.G / 8u); MISC[12] = even ? (bar.x + 8u * MISC[10]) : (unsigned)F.blk; }
        __syncthreads(); F.vblk = (int)MISC[12]; }
#endif
    if (IN(1)) { REFRESH(); phase1(F); if (BOTH(1)) GRID_BAR(); if (REP(1)) { REFRESH(); phase1(F); GRID_BAR(); } }
    if (IN(2)) {
      const bool cv_first = (F.vblk & 1) == 0;
#pragma unroll 1
      for (int st_ = 0; st_ < 3; ++st_) {
        if (st_ == 1) {
          typedef pg8::DenseSched<4096, WS_H, WS_WIN, T / 256, ZW / 256> Sch; Sch S{F.G, F.vblk}; pg8::EpiZ E;
          typedef pg8::AuxW1<21, 3> AX; const int ngw_ = F.G * NWAVES; const AX X{F.blk * NWAVES + F.wave, ngw_, (AX::TOTAL + ngw_ - 1) / ngw_};
          const int done = pg8::gemm_phase<pg8::EpiZ, Sch, true, true, false, AX>(F.lds + RING_OFF, S, E, F.wave, X);
#pragma unroll 1
          for (int j = done; j < X.nsl; ++j) { f32x4 v[8]; const int ln_ = lane_id(); X.issue(v, j, F.wave, ln_); X.consume(v, j, F.wave, ln_); }
        } else if ((st_ == 0) == cv_first) { REFRESH(); convert_big(F, cv_first); __syncthreads(); }
      }
      if (BOTH(2)) GRID_BAR();
    }
    if (IN(3)) { REFRESH(); phase3(F); if (BOTH(3)) GRID_BAR(); if (REP(3)) { REFRESH(); phase3(F); GRID_BAR(); } }
    if (IN(4)) {
#pragma unroll 1
      for (int rp_ = 0; rp_ < (REP(4) ? 2 : 1); ++rp_) {
        typedef pg8::DenseSched<4096, WS_MIX, WS_WOUT, T / 256, D / 256, true> Sch; Sch S{F.G, F.vblk}; pg8::EpiRes E;
        pg8::gemm_phase<pg8::EpiRes, Sch, true, true, false>(F.lds + RING_OFF, S, E, F.wave);
        if (BOTH(4)) GRID_BAR();
      }
    }
    if (IN(5)) { REFRESH(); phase5(F); if (BOTH(5)) GRID_BAR(); }
    if (IN(6) || IN(7)) {
        REFRESH();
        LAS int* tstart = (LAS int*)(F.lds + MOE_OFF); LAS int* ecnt = tstart + 40;
        if (F.tid < 64) { int n = 0; if (F.tid < NE) n = (int)__hip_atomic_load(ctl + CW_CNT + 64 * F.tid, __ATOMIC_RELAXED, __HIP_MEMORY_SCOPE_AGENT);
            int tiles = (n + 255) >> 8, incl = tiles;
#pragma unroll
            for (int o = 1; o < 32; o <<= 1) { const int v = __shfl_up(incl, o); if ((F.tid & 63) >= o) incl += v; }
            if (F.tid < NE) { tstart[F.tid] = incl - tiles; ecnt[F.tid] = n; }
            if (F.tid == NE - 1) tstart[NE] = incl; }
        LDS_WAIT(); __syncthreads();
        const int ntiles = __builtin_amdgcn_readfirstlane(tstart[NE]);
        if (IN(6)) {
          {
            typedef pg8::MoeSched<true, 2048, WS_H8, WS_W1T, (size_t)4096 * D, 16> Sch; Sch S{ntiles, F.G, F.vblk}; pg8::EpiSwiglu E;
            const int ngw_ = F.G * NWAVES; const pg8::AuxW2 X{F.blk * NWAVES + F.wave, ngw_, (pg8::AuxW2::TOTAL + ngw_ - 1) / ngw_};
            const int done = pg8::gemm_phase<pg8::EpiSwiglu, Sch, true, true, true, pg8::AuxW2>(F.lds + RING_OFF, S, E, F.wave, X);
#pragma unroll 1
            for (int j = done; j < X.nsl; ++j) { f32x4 v[8]; const int ln_ = lane_id(); X.issue(v, j, F.wave, ln_); X.consume(v, j, F.wave, ln_); }
            if (BOTH(6)) GRID_BAR();
            if (REP(6)) { pg8::gemm_phase<pg8::EpiSwiglu, Sch, true, true, true>(F.lds + RING_OFF, S, E, F.wave); GRID_BAR(); }
          }
        }
        if (IN(7)) {
          {
            typedef pg8::MoeSched<false, 2048, WS_ACT, WS_W2T, (size_t)D * D, 8> Sch; Sch S{ntiles, F.G, F.vblk}; pg8::EpiY E;
            pg8::gemm_phase<pg8::EpiY, Sch, true, true, true>(F.lds + RING_OFF, S, E, F.wave);
            if (BOTH(7)) GRID_BAR();
            if (REP(7)) { pg8::gemm_phase<pg8::EpiY, Sch, true, true, true>(F.lds + RING_OFF, S, E, F.wave); GRID_BAR(); }
          }
        }
    }
    if (IN(8)) { REFRESH(); phase8(F); if (REP(8)) { GRID_BAR(); REFRESH(); phase8(F); } }
#undef IN
#undef BOTH
}

extern "C" void kernel_launch(void* const* d_in, const int* in_sizes, int n_in, void* d_out, int out_size, void* d_ws, size_t ws_size, hipStream_t stream) {
    static int grid = 0;
    if (grid == 0) {
        if (n_in != 23 || out_size != T * D || ws_size < WS_END) { fprintf(stderr, "kernel_launch: unexpected shapes (n_in %d out %d ws %zu)\n", n_in, out_size, ws_size); grid = -1; return; }
        int dev = 0, cus = 0, per_cu = 0;
        if (hipGetDevice(&dev) != hipSuccess || hipDeviceGetAttribute(&cus, hipDeviceAttributeMultiprocessorCount, dev) != hipSuccess) { grid = -1; return; }
        if (hipFuncSetAttribute((const void*)mk_fwd, hipFuncAttributeMaxDynamicSharedMemorySize, LDS_BYTES) != hipSuccess) { fprintf(stderr, "kernel_launch: hipFuncSetAttribute failed\n"); grid = -1; return; }
        if (hipOccupancyMaxActiveBlocksPerMultiprocessor(&per_cu, (const void*)mk_fwd, NTHR, LDS_BYTES) != hipSuccess || per_cu < 1) fprintf(stderr, "kernel_launch: occupancy query says %d\n", per_cu);
        (void)hipGetLastError();
        grid = cus;
    }
    if (grid < 0) return;
    if (hipMemsetAsync((char*)d_ws + WS_CTL, 0, CTL_ZERO_BYTES, stream) != hipSuccess) return;
    Args a{};
    for (int i = 0; i < 23; ++i) a.in[i] = (const float*)d_in[i];
    a.out = (float*)d_out; a.ws = (unsigned char*)d_ws;
#if MK_PER_PHASE
    for (int ph = 0; ph < 9; ++ph) { a.ph_lo = ph; a.ph_hi = ph + 1; hipLaunchKernelGGL(mk_fwd, dim3(grid), dim3(NTHR), LDS_BYTES, stream, a); }
#else
    a.ph_lo = 0; a.ph_hi = 9; hipLaunchKernelGGL(mk_fwd, dim3(grid), dim3(NTHR), LDS_BYTES, stream, a);
#endif
    (void)in_sizes;
}
```

```cpp
#include <hip/hip_runtime.h>
#include <cstdio>
#include <cstdint>

#ifndef MK_PER_PHASE
#define MK_PER_PHASE 0
#endif

#define GAS __attribute__((address_space(1)))
#define LAS __attribute__((address_space(3)))
typedef unsigned short bf16;
typedef unsigned v4u __attribute__((ext_vector_type(4)));
typedef unsigned v2u __attribute__((ext_vector_type(2)));
typedef float f32x4 __attribute__((ext_vector_type(4)));
typedef float f32x2 __attribute__((ext_vector_type(2)));
typedef short bf16x8 __attribute__((ext_vector_type(8)));

constexpr int NB = 2, SEQ = 16384, T = NB * SEQ, D = 2048, ZW = 3072, NE = 32, TOPK = 4;
constexpr int LCAP = 32768;
constexpr int MAXTILES = T * TOPK / 256 + NE;
constexpr float RMS_EPS = 1e-5f, LN_EPS = 1e-5f;
constexpr int NWAVES = 8, NTHR = 512;

constexpr size_t MiB = 1u << 20;
constexpr size_t WS_CTL = 0, CTL_ZERO_BYTES = 1 * MiB;
constexpr size_t WS_MODP = 1 * MiB;
constexpr size_t WS_MOD = 1 * MiB + 512 * 1024;
constexpr size_t WS_WSB = 2 * MiB;
constexpr size_t WS_PWT = 3 * MiB;
constexpr size_t WS_WIN = 4 * MiB;
constexpr size_t WS_WOUT = 16 * MiB;
constexpr size_t WS_RA = 296 * MiB, WS_RB = 297 * MiB;
constexpr size_t WS_RWP = 298 * MiB;
constexpr size_t WS_LGATE = 288 * MiB;

constexpr size_t WS_LIST = 26 * MiB;
constexpr size_t WS_W1T = 32 * MiB;
constexpr size_t WS_W2T = 544 * MiB;
constexpr size_t WS_H = 800 * MiB;
constexpr size_t WS_H8 = 864 * MiB;
constexpr size_t WS_Z = 928 * MiB;
constexpr size_t WS_MIX = 1120 * MiB;
constexpr size_t WS_X1 = 1248 * MiB;
constexpr size_t WS_ACT = 1504 * MiB;
constexpr size_t WS_Y4 = 2048 * MiB;
constexpr size_t WS_END = 2560 * MiB;
constexpr int CW_BAR = 4096;
constexpr int CW_CNT = 16384;

constexpr int RING_OFF = 0, RING_BYTES = 131072;
constexpr int TAB_OFF = 131072;
constexpr int ROWTAB_OFF = 147456;
constexpr int MOE_OFF = 149504;
constexpr int MISC_OFF = 150016;
constexpr int TBL_OFF = 150528;
constexpr int LDS_BYTES = 156672;

#define LDS_WAIT() asm volatile("s_waitcnt lgkmcnt(0)" ::: "memory")
#define VM_WAIT() asm volatile("s_waitcnt vmcnt(0)" ::: "memory")

__device__ __forceinline__ unsigned cvt_pk_bf16(float lo, float hi) { unsigned r; asm("v_cvt_pk_bf16_f32 %0, %1, %2" : "=v"(r) : "v"(lo), "v"(hi)); return r; }
__device__ __forceinline__ float bf_lo(unsigned w) { return __uint_as_float(w << 16); }
__device__ __forceinline__ float bf_hi(unsigned w) { return __uint_as_float(w & 0xffff0000u); }
__device__ __forceinline__ int lane_id() { int l; asm volatile("v_mbcnt_lo_u32_b32 %0, -1, 0\n\tv_mbcnt_hi_u32_b32 %0, -1, %0" : "=v"(l)); return l; }
__device__ __forceinline__ float wave_sum(float v) {
#pragma unroll
    for (int o = 1; o < 64; o <<= 1) v += __shfl_xor(v, o);
    return v;
}

#define XB_TMO      128
#define XB_XCNT(j)  (256  + 64 * (j))
#define XB_XSUB(j)  (1280 + 64 * (j))
#define XB_XGEN(j)  (2304 + 64 * (j))
#define XB_TOP      3328
#define XB_TOPGEN   3392
#define XCD_BAR_WORDS 3456
#define XB_SPIN_CAP (1u << 18)
__device__ __forceinline__ unsigned xb_ld(unsigned* p)              { return __hip_atomic_load(p, __ATOMIC_RELAXED, __HIP_MEMORY_SCOPE_AGENT); }
__device__ __forceinline__ unsigned xb_add(unsigned* p, unsigned v) { return __hip_atomic_fetch_add(p, v, __ATOMIC_RELAXED, __HIP_MEMORY_SCOPE_AGENT); }
__device__ __forceinline__ unsigned xb_xcc_id() { return (unsigned)__builtin_amdgcn_s_getreg((3 << 11) | 20) & 0xFu; }
#define XB_SPIN(cond, bar) do { unsigned _sp = 0; while (cond) { __builtin_amdgcn_s_sleep(1); \
    if ((++_sp & 255u) == 0u) { if (xb_ld(&(bar)[XB_TMO])) break; if (_sp > XB_SPIN_CAP) { atomicAdd(&(bar)[XB_TMO], 1u); break; } } } } while (0)
struct XcdBarrier { unsigned* bar; unsigned x; volatile LAS unsigned* st; };
__device__ __forceinline__ XcdBarrier xcd_barrier_post(unsigned* bar, volatile LAS unsigned* st, bool leader) {
    XcdBarrier b; b.bar = bar; b.x = xb_xcc_id(); b.st = st;
    if (leader) st[2] = xb_add(&bar[XB_XCNT(b.x)], 1u);
    return b;
}
__device__ __forceinline__ void xcd_barrier_complete(unsigned* bar, unsigned x, unsigned& nloc, unsigned& nx) {
    const unsigned G = gridDim.x * gridDim.y * gridDim.z;
    unsigned sum, cnt, mine, sp = 0u;
    for (;;) {
        sum = 0u; cnt = 0u; mine = 0u;
#pragma unroll
        for (unsigned j = 0; j < 16; ++j) { const unsigned c = xb_ld(&bar[XB_XCNT(j)]); sum += c; cnt += (c > 0u) ? 1u : 0u; mine = (j == x) ? c : mine; }
        if (sum == G) break;
        __builtin_amdgcn_s_sleep(1);
        if ((++sp & 255u) == 0u) { if (xb_ld(&bar[XB_TMO])) break; if (sp > XB_SPIN_CAP) { atomicAdd(&bar[XB_TMO], 1u); break; } }
    }
    nloc = mine > 0u ? mine : 1u; nx = cnt > 0u ? cnt : 1u;
}
__device__ __forceinline__ void xcd_barrier(const XcdBarrier& b, bool leader) {
    asm volatile("s_waitcnt vmcnt(0)" ::: "memory");
    __syncthreads();
    if (leader) {
        unsigned* bar = b.bar;
        __builtin_amdgcn_s_waitcnt(0);
        unsigned nloc = b.st[0], nx = b.st[1];
        if (nloc == 0u) { xcd_barrier_complete(bar, b.x, nloc, nx); b.st[0] = nloc; b.st[1] = nx; }
        const unsigned old = xb_add(&bar[XB_XSUB(b.x)], 1u);
        const unsigned gen = old / nloc;
        if (old + 1u == (gen + 1u) * nloc) {
            __builtin_amdgcn_fence(__ATOMIC_RELEASE, "agent");
            asm volatile("s_waitcnt vmcnt(0)" ::: "memory");
            const unsigned og = xb_add(&bar[XB_TOP], 1u);
            const unsigned tg = og / nx;
            if (og + 1u == (tg + 1u) * nx) xb_add(&bar[XB_TOPGEN], 1u);
            else XB_SPIN(xb_ld(&bar[XB_TOPGEN]) == tg, bar);
            __builtin_amdgcn_fence(__ATOMIC_ACQUIRE, "agent");
            xb_add(&bar[XB_XGEN(b.x)], 1u);
            asm volatile("s_waitcnt vmcnt(0)" ::: "memory");
        } else {
            XB_SPIN(xb_ld(&bar[XB_XGEN(b.x)]) == gen, bar);
            __builtin_amdgcn_fence(__ATOMIC_ACQUIRE, "agent");
            asm volatile("s_waitcnt vmcnt(0)" ::: "memory");
        }
    }
    __syncthreads();
}

struct Args { const float* in[23]; float* out; unsigned char* ws; int ph_lo, ph_hi; };
enum { I_X = 0, I_C, I_MIXG, I_WADA, I_BADA, I_WIN, I_LNG, I_LNB, I_GWS, I_GBS, I_POOLW, I_POOLS, I_GOUTG, I_POUTG, I_WOUT, I_FFNG, I_RW, I_RB, I_W1, I_B1, I_W2, I_B2, I_FING };

typedef __attribute__((address_space(4))) const Args* KArgs;
__device__ __forceinline__ KArgs kargs() { KArgs p = (KArgs)__builtin_amdgcn_kernarg_segment_ptr(); asm volatile("" : "+s"(p)); return p; }
namespace pg8 {
constexpr int BM = 256, BK = 64, HALF = 128, HTB = HALF * BK * 2, STAGE_BYTES = 8 * HTB, NXCD = 8, WGM = 8;
constexpr int K = 2048, NT = K / BK;
__host__ __device__ __forceinline__ int lds_byte(int r, int c) { const int st = (r >> 4) * 2 + (c >> 5), rr = r & 15, cc = c & 31, ob = rr * 64 + cc * 2; return st * 1024 + (ob ^ (((ob >> 9) & 1) << 5)); }
__host__ __device__ __forceinline__ void stage_rc(int b, int& R, int& C) { const int st = b / 1024, sb = b % 1024, swz = sb ^ (((sb >> 9) & 1) << 5); R = (st >> 1) * 16 + swz / 64; C = (st & 1) * 32 + (swz % 64) / 2; }
__host__ __device__ __forceinline__ int lds_byte8(int r, int cb) { const int st = (r >> 4) * 2 + (cb >> 6), rr = r & 15, ob = rr * 64 + (cb & 63); return st * 1024 + (ob ^ (((ob >> 9) & 1) << 4)); }
__host__ __device__ __forceinline__ void stage_rc8(int b, int& R, int& Cb) { const int st = b / 1024, sb = b % 1024, swz = sb ^ (((sb >> 9) & 1) << 4); R = (st >> 1) * 16 + swz / 64; Cb = (st & 1) * 64 + (swz % 64); }
typedef int v4i __attribute__((ext_vector_type(4)));
typedef int v8i __attribute__((ext_vector_type(8)));
__device__ __forceinline__ unsigned pk_fp8x4(float a, float b, float c, float d) { int w = 0; w = __builtin_amdgcn_cvt_pk_fp8_f32(a, b, w, false); w = __builtin_amdgcn_cvt_pk_fp8_f32(c, d, w, true); return (unsigned)w; }
constexpr float Y8_SCALE = 8.0f, Y8_INV = 1.0f / 8.0f;
constexpr float W8_SCALE = 256.0f, W8_INV = 1.0f / 256.0f;
__host__ __device__ __forceinline__ int perm32(int rho) { const int n = rho >> 4, i = rho & 15; return 8 * (i >> 2) + 4 * n + (i & 3); }

struct Unit { int pm, pn, e, ml; };

__device__ __forceinline__ bool order_next(int i, int G, int c, int nM, int nN, Unit& u) {
    const int nwg = nM * nN; const int L = i * G + c; if (L >= nwg) return false;
    int wgid = L; { const int q = nwg / NXCD, r = nwg % NXCD, xcd = wgid % NXCD, off = wgid / NXCD; wgid = (xcd < r ? xcd * (q + 1) : r * (q + 1) + (xcd - r) * q) + off; }
    const int nig = WGM * nN, gid = wgid / nig, fm = gid * WGM, gsz = (nM - fm) < WGM ? (nM - fm) : WGM;
    u.pm = fm + ((wgid % nig) % gsz); u.pn = (wgid % nig) / gsz; u.e = 0; u.ml = 0; return true;
}
template <int ROWB, size_t WS_A, size_t WS_B, int NM, int NN, bool ROWFAC = false> struct DenseSched {
    int G, c;
    __device__ __forceinline__ bool next(int i, Unit& u) const { return order_next(i, G, c, NM, NN, u); }
    __device__ __forceinline__ const char* a_base() const { return (const char*)(kargs()->ws + WS_A); }
    __device__ __forceinline__ const char* b_ptr(const Unit& u) const { return (const char*)(kargs()->ws + WS_B) + (size_t)u.pn * (256 * ROWB); }
    __device__ __forceinline__ bool need_prep(const Unit&, const Unit&) const { return false; }
    __device__ __forceinline__ void prep(const Unit&, int, int) const {}
    __device__ __forceinline__ void tables(const Unit& u, int eslot, int wid, int lane) const {
        if (ROWFAC) { if (wid < 2) { const char* src = (const char*)(kargs()->ws + (wid == 0 ? WS_RA : WS_RB)) + (size_t)u.pm * 1024 + 16 * lane;
                __builtin_amdgcn_global_load_lds((const unsigned*)src, (LAS unsigned*)(size_t)(TBL_OFF + eslot * 3072 + 1024 * wid), 16, 0, 0); } }
    }
    __device__ __forceinline__ void a_off(const Unit& u, int, const int (&Ri)[2], const int (&Ci2)[2], unsigned (&o)[2][2]) const {
#pragma unroll
        for (int h = 0; h < 2; ++h)
#pragma unroll
            for (int i = 0; i < 2; ++i) o[h][i] = (unsigned)(u.pm * 256 + h * 128 + Ri[i]) * (unsigned)ROWB + (unsigned)Ci2[i];
    }
};
template <bool GATHER, int ROWB, size_t WS_A, size_t WS_B, size_t BSTRIDE, int NN> struct MoeSched {
    int nM, G, c;
    __device__ __forceinline__ static const LAS int* tstart() { return (const LAS int*)(size_t)MOE_OFF; }
    __device__ __forceinline__ static const LAS int* ecnt() { return (const LAS int*)(size_t)(MOE_OFF + 160); }
    __device__ __forceinline__ static LAS unsigned* rowtab() { return (LAS unsigned*)(size_t)ROWTAB_OFF; }
    __device__ __forceinline__ bool next(int i, Unit& u) const {
        if (!order_next(i, G, c, nM, NN, u)) return false;
        int e = 0;
#pragma unroll
        for (int k = 1; k < NE; ++k) e += (tstart()[k] <= u.pm) ? 1 : 0;
        e = __builtin_amdgcn_readfirstlane(e);
        u.e = e; u.ml = u.pm - __builtin_amdgcn_readfirstlane(tstart()[e]); return true;
    }
    __device__ __forceinline__ const char* a_base() const { return (const char*)(kargs()->ws + WS_A); }
    __device__ __forceinline__ const char* b_ptr(const Unit& u) const { return (const char*)(kargs()->ws + WS_B) + (size_t)u.e * BSTRIDE + (size_t)u.pn * (256 * ROWB); }
    __device__ __forceinline__ bool need_prep(const Unit& a, const Unit& b) const { return GATHER && (a.pm != b.pm); }
    __device__ __forceinline__ void prep(const Unit& u, int slot, int tid) const {
        if (GATHER) {
            if (tid < 256) { const int* list = (const int*)(kargs()->ws + WS_LIST); const int a = 256 * u.ml + tid; const int n = ecnt()[u.e]; int ent = 0; if (a < n) ent = list[(size_t)u.e * LCAP + a];
                rowtab()[slot * 256 + tid] = (unsigned)(ent >> 2) * (unsigned)ROWB; } }
    }
    __device__ __forceinline__ void tables(const Unit& u, int eslot, int wid, int lane) const {
        KArgs ap = kargs(); LAS unsigned char* tb = (LAS unsigned char*)(size_t)(TBL_OFF + eslot * 3072);
        if (GATHER) { if (wid == 0) { const float* src = ap->in[I_B1] + (size_t)u.e * 4096 + (lane < 32 ? 128 * u.pn + 4 * lane : 2048 + 128 * u.pn + 4 * (lane - 32));
                __builtin_amdgcn_global_load_lds((const unsigned*)src, (LAS unsigned*)tb, 16, 0, 0); } }
        else { if (wid < 3) { const char* src = wid == 0 ? (const char*)(ap->in[I_B2] + (size_t)u.e * D + 256 * u.pn) : (const char*)(ap->ws + (wid == 1 ? WS_LIST : WS_LGATE)) + ((size_t)u.e * LCAP + 256 * u.ml) * 4;
                __builtin_amdgcn_global_load_lds((const unsigned*)(src + 16 * lane), (LAS unsigned*)(tb + 1024 * wid), 16, 0, 0); } }
    }
    __device__ __forceinline__ void a_off(const Unit& u, int slot, const int (&Ri)[2], const int (&Ci2)[2], unsigned (&o)[2][2]) const {
#pragma unroll
        for (int h = 0; h < 2; ++h)
#pragma unroll
            for (int i = 0; i < 2; ++i) {
                if (GATHER) o[h][i] = rowtab()[slot * 256 + h * 128 + Ri[i]] + (unsigned)Ci2[i];
                else o[h][i] = (unsigned)(u.pm * 256 + h * 128 + Ri[i]) * (unsigned)ROWB + (unsigned)Ci2[i];
            }
    }
};

__device__ __forceinline__ f32x2 gelu_pk(f32x2 v) {
    const f32x2 av = __builtin_elementwise_abs(v), d = av * 0.2316418882f + 1.0f;
    f32x2 t; t.x = __builtin_amdgcn_rcpf(d.x); t.y = __builtin_amdgcn_rcpf(d.y);
    f32x2 q = t * 0.5307027145f + (-0.7265760135f); q = q * t + 0.7107068705f; q = q * t + (-0.142248368f); q = q * t + 0.127414796f; q = q * t;
    const f32x2 s = (v * v) * (-0.72134752044f);
    f32x2 e; e.x = __builtin_amdgcn_exp2f(s.x); e.y = __builtin_amdgcn_exp2f(s.y);
    const f32x2 m = v * (q * e), r = v - m;
    f32x2 o; o.x = v.x < 0.f ? m.x : r.x; o.y = v.y < 0.f ? m.y : r.y; return o;
}

struct EpiZ {
    static constexpr bool PERM = true, HAS_MID = false;
    __device__ __forceinline__ void operator()(const f32x4 (&acc)[2][2][4][2], const Unit& u, int wr, int wc, int fr, int fq, int eslot) const {
        bf16* Z = (bf16*)(kargs()->ws + WS_Z);
        const int row0 = u.pm * BM + wr * 64 + fr, col0 = u.pn * BM + wc * 64 + 16 * fq; const bool act = u.pn < 8;
#pragma unroll
        for (int ai = 0; ai < 2; ++ai)
#pragma unroll
            for (int m = 0; m < 4; ++m) { bf16* rowp = Z + (size_t)(row0 + ai * HALF + m * 16) * ZW + col0;
#pragma unroll
                for (int bj = 0; bj < 2; ++bj) { f32x4 v0 = acc[ai][bj][m][0], v1 = acc[ai][bj][m][1];
                    if (act) { f32x2 a = gelu_pk((f32x2){v0[0], v0[1]}), b = gelu_pk((f32x2){v0[2], v0[3]}), c = gelu_pk((f32x2){v1[0], v1[1]}), d = gelu_pk((f32x2){v1[2], v1[3]});
                        v0 = (f32x4){a.x, a.y, b.x, b.y}; v1 = (f32x4){c.x, c.y, d.x, d.y}; }
                    v4u w; w.x = cvt_pk_bf16(v0[0], v0[1]); w.y = cvt_pk_bf16(v0[2], v0[3]); w.z = cvt_pk_bf16(v1[0], v1[1]); w.w = cvt_pk_bf16(v1[2], v1[3]);
                    *(v4u*)(rowp + bj * 8) = w; } }
    }
};
struct EpiRes {
    static constexpr bool PERM = true, HAS_MID = true;
    __device__ __forceinline__ void mid(f32x4 (&acc)[2][2][4][2], int wr, int fr, int eslot) const {
        const LAS float* ra = (const LAS float*)(size_t)(TBL_OFF + eslot * 3072); const LAS float* rb = ra + 256;
#pragma unroll
        for (int ai = 0; ai < 2; ++ai)
#pragma unroll
            for (int m = 0; m < 4; ++m) { const int r = ai * HALF + wr * 64 + m * 16 + fr; const float f = ra[r] * __builtin_amdgcn_rcpf(rb[r]);
#pragma unroll
                for (int bj = 0; bj < 2; ++bj)
#pragma unroll
                    for (int n = 0; n < 2; ++n) acc[ai][bj][m][n] = acc[ai][bj][m][n] * f; }
    }
    __device__ __forceinline__ void operator()(const f32x4 (&acc)[2][2][4][2], const Unit& u, int wr, int wc, int fr, int fq, int eslot) const {
        KArgs ap = kargs(); const float* x = ap->in[I_X]; bf16* x1 = (bf16*)(ap->ws + WS_X1); const float* mod = (const float*)(ap->ws + WS_MOD);
        const int row0 = u.pm * BM + wr * 64 + fr, col0 = u.pn * BM + wc * 64 + 16 * fq; const int b = (u.pm * BM) >= SEQ ? 1 : 0;
        f32x4 gm[2][2];
#pragma unroll
        for (int bj = 0; bj < 2; ++bj)
#pragma unroll
            for (int n = 0; n < 2; ++n) gm[bj][n] = *(const f32x4*)(mod + b * 12288 + 2 * D + col0 + bj * 8 + 4 * n);
#pragma unroll
        for (int ai = 0; ai < 2; ++ai) {
            f32x4 xs[4][2][2];
#pragma unroll
            for (int m = 0; m < 4; ++m)
#pragma unroll
                for (int bj = 0; bj < 2; ++bj) { const float* xp = x + (size_t)(row0 + ai * HALF + m * 16) * D + col0 + bj * 8; xs[m][bj][0] = *(const f32x4*)xp; xs[m][bj][1] = *(const f32x4*)(xp + 4); }
            asm volatile("" ::: "memory");
#pragma unroll
            for (int m = 0; m < 4; ++m) { const size_t off = (size_t)(row0 + ai * HALF + m * 16) * D + col0; const float rbv = ((const LAS float*)(size_t)(TBL_OFF + eslot * 3072 + 1024))[ai * HALF + wr * 64 + m * 16 + fr];
#pragma unroll
                for (int bj = 0; bj < 2; ++bj) {
                    const f32x4 o0 = xs[m][bj][0] + gm[bj][0] * (acc[ai][bj][m][0] * rbv), o1 = xs[m][bj][1] + gm[bj][1] * (acc[ai][bj][m][1] * rbv);
                    v4u w; w.x = cvt_pk_bf16(o0[0], o0[1]); w.y = cvt_pk_bf16(o0[2], o0[3]); w.z = cvt_pk_bf16(o1[0], o1[1]); w.w = cvt_pk_bf16(o1[2], o1[3]);
                    *(v4u*)(x1 + off + bj * 8) = w; }
                __builtin_amdgcn_sched_barrier(0); }
            asm volatile("" ::: "memory");
        }
    }
};
struct EpiSwiglu {
    static constexpr bool PERM = true, HAS_MID = false, HALVES = true;
    template <int AI> __device__ __forceinline__ void half(const f32x4 (&acc)[2][2][4][2], const Unit& u, int wr, int wc, int fr, int fq, int eslot) const {
        KArgs ap = kargs(); unsigned char* ACT = ap->ws + WS_ACT;
        const LAS float* btab = (const LAS float*)(size_t)(TBL_OFF + eslot * 3072) + wc * 32 + 8 * fq;
        const int row0 = u.pm * BM + wr * 64 + fr, colj = u.pn * HALF + wc * 32 + 8 * fq;
        constexpr int ai = AI;
#pragma unroll
            for (int m = 0; m < 4; ++m) { unsigned char* rowp = ACT + (size_t)(row0 + ai * HALF + m * 16) * D + colj; unsigned ow[2];
#pragma unroll
                for (int n = 0; n < 2; ++n) { const f32x4 g4 = acc[ai][0][m][n] * W8_INV + *(const LAS f32x4*)(btab + 4 * n), l4 = acc[ai][1][m][n] * W8_INV + *(const LAS f32x4*)(btab + 128 + 4 * n); float o[4];
#pragma unroll
                    for (int j = 0; j < 4; ++j) { const float g = fminf(g4[j], 7.0f), l = fminf(fmaxf(l4[j], -7.0f), 7.0f);
                        const float sg = __builtin_amdgcn_rcpf(1.0f + __builtin_amdgcn_exp2f(-2.45546696f * g)); o[j] = g * sg * (l + 1.0f); }
                    ow[n] = pk_fp8x4(o[0], o[1], o[2], o[3]); }
                v2u w; w.x = ow[0]; w.y = ow[1];
                *(v2u*)rowp = w; }
    }
    __device__ __forceinline__ void operator()(const f32x4 (&acc)[2][2][4][2], const Unit& u, int wr, int wc, int fr, int fq, int eslot) const {
        half<0>(acc, u, wr, wc, fr, fq, eslot); half<1>(acc, u, wr, wc, fr, fq, eslot);
    }
};
struct EpiY {
    static constexpr bool PERM = true, HAS_MID = false;
    __device__ __forceinline__ void operator()(const f32x4 (&acc)[2][2][4][2], const Unit& u, int wr, int wc, int fr, int fq, int eslot) const {
        KArgs ap = kargs(); unsigned char* Y4 = ap->ws + WS_Y4;
        const LAS float* btab = (const LAS float*)(size_t)(TBL_OFF + eslot * 3072) + wc * 64 + 16 * fq;
        const LAS int* etab = (const LAS int*)(size_t)(TBL_OFF + eslot * 3072 + 1024); const LAS float* gtab = (const LAS float*)(size_t)(TBL_OFF + eslot * 3072 + 2048);
        const int col0 = u.pn * BM + wc * 64 + 16 * fq; const int n_e = ((const LAS int*)(size_t)(MOE_OFF + 160))[u.e];
#pragma unroll
        for (int ai = 0; ai < 2; ++ai)
#pragma unroll
            for (int m = 0; m < 4; ++m) { const int r = ai * HALF + wr * 64 + m * 16 + fr;
                if (256 * u.ml + r < n_e) { const int ent = etab[r]; const float gt = gtab[r] * Y8_SCALE; unsigned char* rowp = Y4 + (size_t)ent * D + col0;
                    v4u w;
#pragma unroll
                    for (int bj = 0; bj < 2; ++bj) { const f32x4 b0 = *(const LAS f32x4*)(btab + bj * 8), b1 = *(const LAS f32x4*)(btab + bj * 8 + 4);
                        const f32x4 v0 = (acc[ai][bj][m][0] * W8_INV + b0) * gt, v1 = (acc[ai][bj][m][1] * W8_INV + b1) * gt;
                        w[2 * bj] = pk_fp8x4(v0[0], v0[1], v0[2], v0[3]); w[2 * bj + 1] = pk_fp8x4(v1[0], v1[1], v1[2], v1[3]); }
                    *(v4u*)rowp = w; } }
    }
};

struct AuxNone { static constexpr bool ON = false; int nsl = 0;
    __device__ __forceinline__ void issue(f32x4 (&)[8], int, int, int) const {} __device__ __forceinline__ void consume(const f32x4 (&)[8], int, int, int) const {} };
struct AuxW2 { static constexpr bool ON = true; static constexpr int TOTAL = 65536; int gw, ngw, nsl;
    __device__ __forceinline__ static void coords(int sid, int lane, int& e, int& k0, int& n0) { const int nb = sid & 63, kb = (sid >> 6) & 31; e = sid >> 11; k0 = 64 * kb + 8 * (lane >> 3); n0 = 32 * nb + 4 * (lane & 7); }
    __device__ __forceinline__ int sid_of(int j) const { const int sid = gw + ngw * j; return sid < TOTAL ? sid : TOTAL - 1; }
    __device__ __forceinline__ void issue(f32x4 (&v)[8], int j, int, int lane) const { int e, k0, n0; coords(sid_of(j), lane, e, k0, n0);
        const float* sp = kargs()->in[I_W2] + (size_t)e * D * D + (unsigned)(k0 * D + n0);
#pragma unroll
        for (int r = 0; r < 8; ++r) v[r] = *(const f32x4*)(sp + r * D); }
    __device__ __forceinline__ void consume(const f32x4 (&v)[8], int j, int, int lane) const { int e, k0, n0; coords(sid_of(j), lane, e, k0, n0);
        unsigned char* dp = kargs()->ws + WS_W2T + (size_t)e * D * D + (unsigned)(n0 * D + k0);
#pragma unroll
        for (int c = 0; c < 4; ++c) { v2u o; o.x = pk_fp8x4(v[0][c] * W8_SCALE, v[1][c] * W8_SCALE, v[2][c] * W8_SCALE, v[3][c] * W8_SCALE); o.y = pk_fp8x4(v[4][c] * W8_SCALE, v[5][c] * W8_SCALE, v[6][c] * W8_SCALE, v[7][c] * W8_SCALE);
            *(v2u*)(dp + c * D) = o; } }
};
template <int E0, int NEXP> struct AuxW1 { static constexpr bool ON = true; static constexpr int TOTAL = NEXP * 4096; int gw, ngw, nsl;
    __device__ __forceinline__ int sid_of(int j) const { const int sid = gw + ngw * j; return sid < TOTAL ? sid : TOTAL - 1; }
    __device__ __forceinline__ void issue(f32x4 (&v)[8], int j, int, int lane) const { const int sid = sid_of(j), kb = (sid >> 7) & 31, nb = sid & 127, e = E0 + (sid >> 12);
        const float* sp = kargs()->in[I_W1] + (size_t)e * D * 4096 + (unsigned)((64 * kb + 8 * (lane >> 3)) * 4096 + 32 * nb + 4 * (lane & 7));
#pragma unroll
        for (int r = 0; r < 8; ++r) v[r] = *(const f32x4*)(sp + r * 4096); }
    __device__ __forceinline__ void consume(const f32x4 (&v)[8], int j, int, int lane) const { const int sid = sid_of(j), kb = (sid >> 7) & 31, nb = sid & 127, e = E0 + (sid >> 12);
        const int n0 = 32 * nb, hf = n0 >> 11, j0 = n0 & 2047, n0p = 256 * (j0 >> 7) + 16 * ((j0 & 127) >> 3) + 8 * hf, nq = lane & 7;
        unsigned char* dp = kargs()->ws + WS_W1T + ((size_t)e * 4096 + n0p + 16 * (nq >> 1) + 4 * (nq & 1)) * D + 64 * kb + 8 * (lane >> 3);
#pragma unroll
        for (int c = 0; c < 4; ++c) { v2u o; o.x = pk_fp8x4(v[0][c] * W8_SCALE, v[1][c] * W8_SCALE, v[2][c] * W8_SCALE, v[3][c] * W8_SCALE); o.y = pk_fp8x4(v[4][c] * W8_SCALE, v[5][c] * W8_SCALE, v[6][c] * W8_SCALE, v[7][c] * W8_SCALE);
            *(v2u*)(dp + (size_t)c * D) = o; } }
};

template <class Epi, class Sched, bool ALIGN_EPI, bool SP2, bool FP8, class Aux = AuxNone>
__device__ __forceinline__ int gemm_phase(LAS unsigned char* lds, const Sched& S, const Epi& E, int wave_, const Aux& X = Aux()) {
    const int wid = wave_, lane = lane_id(), tid = wid * 64 + lane, wr = wid >> 2, wc = wid & 3, fr = lane & 15, fq = lane >> 4;
    constexpr int nt = FP8 ? NT / 2 : NT;
    constexpr int ROWB = FP8 ? K : K * 2;
    unsigned voffB[2];
#pragma unroll
    for (int i = 0; i < 2; ++i) { int R, C; if constexpr (FP8) stage_rc8(tid * 16 + i * 8192, R, C); else { stage_rc(tid * 16 + i * 8192, R, C); C *= 2; }
        int Rb = R; if (Epi::PERM) { const int sp = (R & ~31) + perm32(R & 31); Rb = 16 * (sp >> 3) + (sp & 7); }
        voffB[i] = (unsigned)(Rb * ROWB + C); }
#define PG8_AOFF(unit, slot_, dst) do { const int tl_ = wid * 64 + lane_id(); int Ri_[2], Ci_[2]; _Pragma("unroll") for (int i_ = 0; i_ < 2; ++i_) { int R_, C_; \
        if constexpr (FP8) stage_rc8(tl_ * 16 + i_ * 8192, R_, C_); else { stage_rc(tl_ * 16 + i_ * 8192, R_, C_); C_ *= 2; } Ri_[i_] = R_; Ci_[i_] = C_; } S.a_off(unit, slot_, Ri_, Ci_, dst); } while (0)
    const size_t kstep = (size_t)(BK * 2);
    const size_t hstep = Epi::PERM ? (size_t)8 * ROWB : (size_t)HALF * ROWB;
    const unsigned ldsw = (unsigned)wid * 1024u;
    const int aoff = FP8 ? lds_byte8(wr * 64 + fr, fq * 32) : lds_byte(wr * 64 + fr, fq * 8), boff = FP8 ? lds_byte8(wc * 32 + fr, fq * 32) : lds_byte(wc * 32 + fr, fq * 8);
    const int aof2 = FP8 ? lds_byte8(wr * 64 + fr, fq * 32 + 16) : aoff + 1024, bof2 = FP8 ? lds_byte8(wc * 32 + fr, fq * 32 + 16) : boff + 1024;
#define PG8_SA(b, h) (((b) * 2 + (h)) * HTB)
#define PG8_SB(b, h) ((4 + (b) * 2 + (h)) * HTB)
#define PG8_STAGE(bufoff, gbase, voff) do { _Pragma("unroll") for (int _i = 0; _i < 2; ++_i) { asm volatile("" : "+v"((voff)[_i])); const unsigned vo_ = (voff)[_i];     \
        __builtin_amdgcn_global_load_lds((const unsigned*)((const char*)(gbase) + vo_), (LAS unsigned*)(lds + (bufoff) + ldsw + _i * 8192), 16, 0, 0); } } while (0)
#define PG8_LDA(dst, b, h) do { _Pragma("unroll") for (int m = 0; m < 4; ++m) { dst[m][0] = *(const LAS bf16x8*)(lds + PG8_SA(b, h) + aoff + m * 2048); dst[m][1] = *(const LAS bf16x8*)(lds + PG8_SA(b, h) + aof2 + m * 2048); } } while (0)
#define PG8_LDB(dst, b, h) do { _Pragma("unroll") for (int n = 0; n < 2; ++n) { dst[n][0] = *(const LAS bf16x8*)(lds + PG8_SB(b, h) + boff + n * 2048); dst[n][1] = *(const LAS bf16x8*)(lds + PG8_SB(b, h) + bof2 + n * 2048); } } while (0)
#define PG8_MMA(ai, bj, At, Bt) do { __builtin_amdgcn_s_setprio(1); _Pragma("unroll") for (int m = 0; m < 4; ++m) _Pragma("unroll") for (int n = 0; n < 2; ++n) { \
        if constexpr (FP8) { const v4i b0_ = __builtin_bit_cast(v4i, Bt[n][0]), b1_ = __builtin_bit_cast(v4i, Bt[n][1]), a0_ = __builtin_bit_cast(v4i, At[m][0]), a1_ = __builtin_bit_cast(v4i, At[m][1]); \
            acc[ai][bj][m][n] = __builtin_amdgcn_mfma_scale_f32_16x16x128_f8f6f4(__builtin_shufflevector(b0_, b1_, 0, 1, 2, 3, 4, 5, 6, 7), __builtin_shufflevector(a0_, a1_, 0, 1, 2, 3, 4, 5, 6, 7), acc[ai][bj][m][n], 0, 0, 0, 0x7f7f7f7f, 0, 0x7f7f7f7f); } \
        else { _Pragma("unroll") for (int k = 0; k < 2; ++k) acc[ai][bj][m][n] = __builtin_amdgcn_mfma_f32_16x16x32_bf16(Bt[n][k], At[m][k], acc[ai][bj][m][n], 0, 0, 0); } } \
        __builtin_amdgcn_s_setprio(0); } while (0)
#define PG8_WAIT_V(n) asm volatile("s_waitcnt vmcnt(" #n ")" ::: "memory")
#define PG8_WAIT_L(n) asm volatile("s_waitcnt lgkmcnt(" #n ")" ::: "memory")
#define PG8_BAR __builtin_amdgcn_s_barrier()
#define PG8_SCHED __builtin_amdgcn_sched_barrier(0)
    Unit cur, nxt; int ui = 0;
    if (!S.next(0, cur)) return 0;
    f32x4 acc[2][2][4][2];
#pragma unroll
    for (int a = 0; a < 2; ++a)
#pragma unroll
        for (int b = 0; b < 2; ++b)
#pragma unroll
            for (int m = 0; m < 4; ++m)
#pragma unroll
                for (int n = 0; n < 2; ++n) acc[a][b][m][n] = (f32x4){0.f, 0.f, 0.f, 0.f};
    bf16x8 At[4][2], B0[2][2], B1[2][2];
    const char* const Ab = S.a_base();
    const char* cB = S.b_ptr(cur);
    int slot = 0;
    S.tables(cur, 0, wid, lane);
    S.prep(cur, slot, tid); PG8_WAIT_L(0); PG8_BAR; asm volatile("" ::: "memory");
    unsigned ao[2][2];
    PG8_AOFF(cur, slot, ao);
    if constexpr (SP2) {
        PG8_STAGE(PG8_SB(0, 0), cB, voffB); PG8_STAGE(PG8_SB(0, 1), cB + hstep, voffB); PG8_STAGE(PG8_SA(0, 0), Ab, ao[0]); PG8_STAGE(PG8_SA(0, 1), Ab, ao[1]);
        if (wr == 1) PG8_BAR;
        PG8_WAIT_V(2); PG8_BAR;
        PG8_STAGE(PG8_SB(1, 0), cB + kstep, voffB); PG8_STAGE(PG8_SA(1, 0), Ab + kstep, ao[0]); PG8_STAGE(PG8_SB(1, 1), cB + hstep + kstep, voffB);
        PG8_WAIT_V(6); PG8_BAR;
    } else {
        PG8_STAGE(PG8_SB(0, 0), cB, voffB); PG8_STAGE(PG8_SA(0, 0), Ab, ao[0]); PG8_STAGE(PG8_SB(0, 1), cB + hstep, voffB); PG8_STAGE(PG8_SA(0, 1), Ab, ao[1]);
        if (wr == 1) PG8_BAR;
        PG8_WAIT_V(4); PG8_BAR;
        PG8_STAGE(PG8_SB(1, 0), cB + kstep, voffB); PG8_STAGE(PG8_SA(1, 0), Ab + kstep, ao[0]); PG8_STAGE(PG8_SB(1, 1), cB + hstep + kstep, voffB);
        PG8_WAIT_V(6); PG8_BAR;
    }
    for (;;) {
        const bool has_next = S.next(ui + 1, nxt);
        const char* nB = has_next ? S.b_ptr(nxt) : cB;
        if (ui > 0) S.tables(cur, ui & 1, wid, lane_id());
        if (has_next && S.need_prep(cur, nxt)) { slot ^= 1; S.prep(nxt, slot, wid * 64 + lane_id()); }
        for (int t = 0; t < nt; t += 2) {
            const bool last = (t == nt - 2);
            const char* a1 = Ab + (size_t)(t + 1) * kstep;
            const char* a2 = last ? Ab : Ab + (size_t)(t + 2) * kstep; const char* b2 = last ? nB : cB + (size_t)(t + 2) * kstep;
            const char* a3 = a2 + kstep; const char* b3 = b2 + kstep;
            if constexpr (SP2) {
            static_assert(SP2, "only the two-super-phase loop is kept");
            if constexpr (Epi::HAS_MID) { if (t == nt / 2) E.mid(acc, wr, lane_id() & 15, ui & 1); }
            unsigned ao1c[2] = {ao[1][0], ao[1][1]};
            if (last && has_next) PG8_AOFF(nxt, slot, ao);
            PG8_LDB(B0, 0, 0); PG8_LDB(B1, 0, 1); PG8_SCHED; PG8_LDA(At, 0, 0); PG8_STAGE(PG8_SA(1, 1), a1, ao1c);
            PG8_WAIT_V(8); PG8_WAIT_L(0); PG8_BAR; PG8_MMA(0, 0, At, B0); PG8_MMA(0, 1, At, B1); PG8_BAR; PG8_SCHED;
            PG8_LDA(At, 0, 1); PG8_STAGE(PG8_SB(0, 0), b2, voffB); PG8_STAGE(PG8_SB(0, 1), b2 + hstep, voffB); PG8_STAGE(PG8_SA(0, 0), a2, ao[0]);
            PG8_WAIT_V(8); PG8_WAIT_L(0); PG8_BAR; PG8_MMA(1, 0, At, B0); PG8_MMA(1, 1, At, B1); PG8_BAR; PG8_SCHED;
            PG8_LDB(B0, 1, 0); PG8_LDB(B1, 1, 1); PG8_SCHED; PG8_LDA(At, 1, 0); PG8_STAGE(PG8_SA(0, 1), a2, ao[1]);
            PG8_WAIT_V(8); PG8_WAIT_L(0); PG8_BAR; PG8_MMA(0, 0, At, B0); PG8_MMA(0, 1, At, B1); PG8_BAR; PG8_SCHED;
            PG8_LDA(At, 1, 1); PG8_STAGE(PG8_SB(1, 0), b3, voffB); PG8_STAGE(PG8_SB(1, 1), b3 + hstep, voffB); PG8_STAGE(PG8_SA(1, 0), a3, ao[0]);
            PG8_WAIT_V(8); PG8_WAIT_L(0); PG8_BAR; PG8_MMA(1, 0, At, B0); PG8_MMA(1, 1, At, B1); PG8_BAR; PG8_SCHED;
            }
        }
        if constexpr (ALIGN_EPI) { if (wr == 0) PG8_BAR; }
        if constexpr (Aux::ON) {
            f32x4 xv_[8];
            asm volatile("" ::: "memory"); PG8_SCHED;
            X.issue(xv_, ui < X.nsl ? ui : X.nsl - 1, wid, lane_id());
            asm volatile("" ::: "memory"); PG8_SCHED;
            { const int ln_ = lane_id(); E(acc, cur, wr, wc, ln_ & 15, ln_ >> 4, ui & 1); }
            asm volatile("" ::: "memory"); PG8_SCHED;
            X.consume(xv_, ui < X.nsl ? ui : X.nsl - 1, wid, lane_id());
        } else
        { const int ln_ = lane_id(); E(acc, cur, wr, wc, ln_ & 15, ln_ >> 4, ui & 1); }
        if (!has_next) break;
#pragma unroll
        for (int a = 0; a < 2; ++a)
#pragma unroll
            for (int b = 0; b < 2; ++b)
#pragma unroll
                for (int m = 0; m < 4; ++m)
#pragma unroll
                    for (int n = 0; n < 2; ++n) acc[a][b][m][n] = (f32x4){0.f, 0.f, 0.f, 0.f};
        cur = nxt; cB = nB; ++ui;
        if constexpr (ALIGN_EPI) { if (wr == 1) PG8_BAR; }
    }
    PG8_WAIT_V(0);
    if constexpr (!ALIGN_EPI) { if (wr == 0) PG8_BAR; }
    PG8_BAR;
    return ui + 1;
#undef PG8_AOFF
#undef PG8_SA
#undef PG8_SB
#undef PG8_STAGE
#undef PG8_LDA
#undef PG8_LDB
#undef PG8_MMA
#undef PG8_WAIT_V
#undef PG8_WAIT_L
#undef PG8_BAR
#undef PG8_SCHED
}
}

struct Frame {
    LAS unsigned char* lds;
    unsigned char* ws;
    int tid, lane, wave, G, blk, vblk;
};

__device__ __forceinline__ void phase0(Frame& F, const float* c, const float* w_ada) {
    LAS float* cond = (LAS float*)(F.lds);
    LAS float* red = (LAS float*)(F.lds + 4096);
    float* modp = (float*)(F.ws + WS_MODP);
    for (int item = F.blk; item < 256; item += F.G) {
        const int rg = item & 3, cg = item >> 2;
        for (int i = F.tid; i < 1024; i += NTHR) { const int b = i >> 9, d = i & 511; const float v = c[b * D + 512 * rg + d]; cond[i] = v / (1.0f + __expf(-v)); }
        __syncthreads();
        const int c4 = F.tid % 48, rl = F.tid / 48;
        if (rl < 10) {
            f32x4 a0 = {0.f, 0.f, 0.f, 0.f}, a1 = {0.f, 0.f, 0.f, 0.f};
            const float* wp = w_ada + (size_t)(512 * rg) * 12288 + 192 * cg + 4 * c4;
#pragma unroll 13
            for (int d = rl; d < 512; d += 10) { const f32x4 w = *(const f32x4*)(wp + (size_t)d * 12288); a0 += w * cond[d]; a1 += w * cond[512 + d]; }
            *(LAS f32x4*)(red + (rl * 2 + 0) * 192 + 4 * c4) = a0; *(LAS f32x4*)(red + (rl * 2 + 1) * 192 + 4 * c4) = a1;
        }
        __syncthreads();
        if (F.tid < 384) { const int b = F.tid / 192, col = F.tid % 192; float s = 0.f;
#pragma unroll
            for (int r = 0; r < 10; ++r) s += red[(r * 2 + b) * 192 + col];
            modp[(rg * 2 + b) * 12288 + 192 * cg + col] = s; }
        __syncthreads();
    }
}

__device__ __forceinline__ void tr_item(const float* src, int ld_src, bf16* dst, int ld_dst, const float* kscale, LAS unsigned* scr, int lane) {
    const int kq = lane >> 4, nq = lane & 15;
#pragma unroll 4
    for (int i = 0; i < 16; ++i) { const int k = 8 * i + 2 * kq;
        f32x4 v0 = *(const f32x4*)(src + (size_t)k * ld_src + 4 * nq), v1 = *(const f32x4*)(src + (size_t)(k + 1) * ld_src + 4 * nq);
        if (kscale) { v0 = v0 * kscale[k]; v1 = v1 * kscale[k + 1]; }
#pragma unroll
        for (int j = 0; j < 4; ++j) { const int n = 4 * nq + j; scr[n * 64 + 4 * (i ^ nq) + kq] = cvt_pk_bf16(v0[j], v1[j]); } }
    LDS_WAIT(); asm volatile("" ::: "memory");
#pragma unroll 4
    for (int jj = 0; jj < 16; ++jj) { const int id = jj * 64 + lane, n = id >> 4, c = id & 15;
        const v4u o = *(const LAS v4u*)(scr + n * 64 + 4 * (c ^ ((n >> 2) & 15)));
        *(v4u*)(dst + (size_t)n * ld_dst + 8 * c) = o; }
    LDS_WAIT(); asm volatile("" ::: "memory");
}

template <bool ILV> __device__ __forceinline__ void tr_item8(const float* src, int ld_src, unsigned char* dst, int ld_dst, float scale, LAS unsigned* scr, int lane) {
    const int kq = lane >> 3, nq = lane & 7;
#pragma unroll 8
    for (int i = 0; i < 8; ++i) { const int k = 32 * i + 4 * kq; const float* sp = src + (size_t)k * ld_src + 4 * nq;
        const f32x4 v0 = *(const f32x4*)sp * scale, v1 = *(const f32x4*)(sp + ld_src) * scale, v2 = *(const f32x4*)(sp + 2 * (size_t)ld_src) * scale, v3 = *(const f32x4*)(sp + 3 * (size_t)ld_src) * scale;
#pragma unroll
        for (int j = 0; j < 4; ++j) scr[(4 * nq + j) * 65 + 8 * i + kq] = pg8::pk_fp8x4(v0[j], v1[j], v2[j], v3[j]); }
    LDS_WAIT(); asm volatile("" ::: "memory");
#pragma unroll 4
    for (int jj = 0; jj < 8; ++jj) { const int id = jj * 64 + lane, n = id >> 4, c = id & 15; const LAS unsigned* p = scr + n * 65 + 4 * c;
        v4u o; o.x = p[0]; o.y = p[1]; o.z = p[2]; o.w = p[3];
        *(v4u*)(dst + (size_t)(ILV ? 16 * (n >> 3) + (n & 7) : n) * ld_dst + 16 * c) = o; }
    LDS_WAIT(); asm volatile("" ::: "memory");
}

__device__ __forceinline__ void phase1(Frame& F) {
    KArgs Ap = kargs(); struct { const float* in[23]; } A;
#pragma unroll
    for (int i = 0; i < 23; ++i) A.in[i] = Ap->in[i];
    const float* modp = (const float*)(F.ws + WS_MODP); float* mod = (float*)(F.ws + WS_MOD);
    const float* b_ada = A.in[I_BADA];
    for (int item = F.blk; item < 256; item += F.G) {
        if (F.tid < 96) { const int j = 96 * item + F.tid, b = j / 12288, jj = j % 12288; float s = b_ada[jj];
#pragma unroll
            for (int rg = 0; rg < 4; ++rg) s += modp[(rg * 2 + b) * 12288 + jj];
            mod[j] = s; }
    }
    LAS float* gs = (LAS float*)(F.lds + TAB_OFF); LAS float* sh = gs + D;
    bf16* H = (bf16*)(F.ws + WS_H); const float* x = A.in[I_X]; const float* mixg = A.in[I_MIXG];
    for (int item = F.blk; item < 256; item += F.G) {
        const int b = item >> 7;
        __syncthreads();
        for (int d = F.tid; d < D; d += NTHR) { float sc = b_ada[D + d], sf = b_ada[d];
#pragma unroll
            for (int rg = 0; rg < 4; ++rg) { sc += modp[(rg * 2 + b) * 12288 + D + d]; sf += modp[(rg * 2 + b) * 12288 + d]; }
            gs[d] = mixg[d] * (1.0f + sc); sh[d] = sf; }
        __syncthreads();
        f32x4 vn[4][2];
        { const float* xr = x + (size_t)(128 * item + 16 * F.wave) * D + 8 * F.lane;
#pragma unroll
          for (int j = 0; j < 4; ++j) { vn[j][0] = *(const f32x4*)(xr + 512 * j); vn[j][1] = *(const f32x4*)(xr + 512 * j + 4); } }
#pragma unroll 1
        for (int r = 0; r < 16; ++r) { const int row = 128 * item + 16 * F.wave + r;
            f32x4 v[4][2]; float ss = 0.f;
#pragma unroll
            for (int j = 0; j < 4; ++j) { v[j][0] = vn[j][0]; v[j][1] = vn[j][1]; }
            if (r < 15) { const float* xr = x + (size_t)(row + 1) * D + 8 * F.lane;
#pragma unroll
                for (int j = 0; j < 4; ++j) { vn[j][0] = *(const f32x4*)(xr + 512 * j); vn[j][1] = *(const f32x4*)(xr + 512 * j + 4); } }
#pragma unroll
            for (int j = 0; j < 4; ++j) {
                ss += (v[j][0][0] * v[j][0][0] + v[j][0][1] * v[j][0][1]) + (v[j][0][2] * v[j][0][2] + v[j][0][3] * v[j][0][3]) + (v[j][1][0] * v[j][1][0] + v[j][1][1] * v[j][1][1]) + (v[j][1][2] * v[j][1][2] + v[j][1][3] * v[j][1][3]); }
            const float rstd = 1.0f / sqrtf(wave_sum(ss) * (1.0f / D) + RMS_EPS);
#pragma unroll
            for (int j = 0; j < 4; ++j) { const int col = 8 * F.lane + 512 * j;
                const f32x4 g0 = *(const LAS f32x4*)(gs + col), g1 = *(const LAS f32x4*)(gs + col + 4), s0 = *(const LAS f32x4*)(sh + col), s1 = *(const LAS f32x4*)(sh + col + 4);
                const f32x4 o0 = v[j][0] * rstd * g0 + s0, o1 = v[j][1] * rstd * g1 + s1;
                v4u w; w.x = cvt_pk_bf16(o0[0], o0[1]); w.y = cvt_pk_bf16(o0[2], o0[3]); w.z = cvt_pk_bf16(o1[0], o1[1]); w.w = cvt_pk_bf16(o1[2], o1[3]);
                *(v4u*)(H + (size_t)row * D + col) = w; } }
    }
    { const float* gws = A.in[I_GWS]; unsigned* wsb = (unsigned*)(F.ws + WS_WSB);
      for (int p = F.blk * NTHR + F.tid; p < 8 * 128 * 64; p += F.G * NTHR) { const int j = (p & 63) * 2, i = (p >> 6) & 127;
          const bool keep = (i >> 6) >= (j >> 6); const float a = keep ? gws[2 * p] : 0.f, b = keep ? gws[2 * p + 1] : 0.f; wsb[p] = cvt_pk_bf16(a, b); } }
    { const float* rw = A.in[I_RW]; float* rwp = (float*)(F.ws + WS_RWP);
      for (int p = F.blk * NTHR + F.tid; p < D * NE; p += F.G * NTHR) { const int k = p & 3, ln = (p >> 2) & 63, c = (p >> 8) & 3, eh = (p >> 10) & 1, sI = (p >> 11) & 3, wI = p >> 13;
          rwp[p] = rw[(256 * wI + 64 * sI + 16 * (ln >> 4) + 4 * c + k) * NE + 16 * eh + (ln & 15)]; } }
    LAS unsigned* scr = (LAS unsigned*)(F.lds + RING_OFF + F.wave * 16384);
    const int gw = F.blk * NWAVES + F.wave, NGW = F.G * NWAVES;
    constexpr int I_IN = 16 * 48, I_OUT = 16 * 32, I_PW = 4 * 2 * 4;
    for (int it = gw; it < I_IN + I_OUT + I_PW; it += NGW) {
        int r = it;
        if (r < I_IN) { const int kb = r / 48, nb = r % 48;
            tr_item(A.in[I_WIN] + (size_t)(128 * kb) * ZW + 64 * nb, ZW, (bf16*)(F.ws + WS_WIN) + (size_t)(64 * nb) * D + 128 * kb, D, nullptr, scr, F.lane); continue; }
        r -= I_IN;
        if (r < I_OUT) { const int kb = r >> 5, nb = r & 31; const float* ks = (kb < 8) ? (A.in[I_GOUTG] + 128 * kb) : (A.in[I_POUTG] + 128 * (kb - 8));
            tr_item(A.in[I_WOUT] + (size_t)(128 * kb) * D + 64 * nb, D, (bf16*)(F.ws + WS_WOUT) + (size_t)(64 * nb) * D + 128 * kb, D, ks, scr, F.lane); continue; }
        r -= I_OUT;
        { const int g = r >> 3, kb = (r >> 2) & 1, nb = r & 3;
          tr_item(A.in[I_POOLW] + (size_t)g * 65536 + (size_t)(128 * kb) * 256 + 64 * nb, 256, (bf16*)(F.ws + WS_PWT) + (size_t)g * 65536 + (size_t)(64 * nb) * 256 + 128 * kb, 256, nullptr, scr, F.lane); }
    }
}

#ifndef CV_EXTRA
#define CV_EXTRA 5120
#endif
__device__ __forceinline__ void convert_item(const float* w1, const float* w2, unsigned char* ws, int r, LAS unsigned* scr, int lane) {
    constexpr int I_1 = 32 * 16 * 64;
    if (r < I_1) { const int e = r >> 10, kb = (r >> 7) & 7, nb = r & 127; const int n0 = 32 * nb, half = n0 >> 11, j0 = n0 & 2047, n0p = 256 * (j0 >> 7) + 16 * ((j0 & 127) >> 3) + 8 * half;
        tr_item8<true>(w1 + (size_t)e * D * 4096 + (size_t)(256 * kb) * 4096 + n0, 4096, ws + WS_W1T + ((size_t)e * 4096 + n0p) * D + 256 * kb, D, pg8::W8_SCALE, scr, lane); return; }
    r -= I_1;
    { const int e = r >> 9, kb = (r >> 6) & 7, nb = r & 63;
        tr_item8<false>(w2 + (size_t)e * D * D + (size_t)(256 * kb) * D + 32 * nb, D, ws + WS_W2T + ((size_t)e * D + 32 * nb) * D + 256 * kb, D, pg8::W8_SCALE, scr, lane); }
}
__device__ __forceinline__ void convert_big(Frame& F, bool first) {
    KArgs Ap = kargs(); const float* w1 = Ap->in[I_W1]; const float* w2 = Ap->in[I_W2];
    LAS unsigned* scr = (LAS unsigned*)(F.lds + RING_OFF + F.wave * 16384);
    constexpr int N_ALL = 21 * 16 * 64, N_X = CV_EXTRA;
    if (first) { const int gt = (F.vblk >> 1) * NWAVES + F.wave, NGT = ((F.G + 1) >> 1) * NWAVES;
        for (int it = gt; it < N_X; it += NGT) convert_item(w1, w2, F.ws, it, scr, F.lane); }
    const int gw = F.vblk * NWAVES + F.wave, NGW = F.G * NWAVES;
    for (int it = N_X + gw; it < N_ALL; it += NGW) convert_item(w1, w2, F.ws, it, scr, F.lane);
}

__device__ __forceinline__ int vsw(int d) { return (d & 15) ^ ((d >> 4) & 7); }
__device__ __forceinline__ f32x4 bf4(v2u r) { return (f32x4){bf_lo(r.x), bf_hi(r.x), bf_lo(r.y), bf_hi(r.y)}; }
__device__ __forceinline__ void pool_stage(const bf16* Z, int t0, int tpos0, int g, int rq  , int c4  , LAS unsigned* poolA) {
    const int win = 2 << g;
    const bf16* zu = Z + (size_t)t0 * ZW + 2048 + 256 * g;
    v2u raw[32];
#pragma unroll
    for (int k = 0; k < 32; ++k) { const int t = 16 * rq - 16 + k; const int tc = (tpos0 + t >= 0) ? t : 0; raw[k] = *(const v2u*)(zu + (long)tc * ZW + 4 * c4); if (tpos0 + t < 0) raw[k] = (v2u){0u, 0u}; }
    f32x4 S = {0.f, 0.f, 0.f, 0.f};
#pragma unroll
    for (int k = 0; k < 16; ++k) { const f32x4 p = bf4(raw[k]); if (k >= 16 - win) S += p; }
#pragma unroll
    for (int j = 0; j < 16; ++j) { const int t = 16 * rq + j;
        const f32x4 p = bf4(raw[16 + j]);
        const v2u qr = (win == 2) ? raw[14 + j] : (win == 4) ? raw[12 + j] : (win == 8) ? raw[8 + j] : raw[j];
        S = S + p - bf4(qr);
        const int cn = (tpos0 + t + 1) < win ? (tpos0 + t + 1) : win; const float ic = 1.0f / (float)cn;
        const f32x4 o = S * ic - p;
        v2u w; w.x = cvt_pk_bf16(o[0], o[1]); w.y = cvt_pk_bf16(o[2], o[3]);
        *(LAS v2u*)(poolA + t * 128 + 4 * ((c4 >> 1) ^ (t & 15)) + 2 * (c4 & 1)) = w; }
}
__device__ __forceinline__ void phase3(Frame& F) {
    KArgs Ap = kargs(); struct { const float* in[23]; } A;
    A.in[I_LNG] = Ap->in[I_LNG]; A.in[I_LNB] = Ap->in[I_LNB]; A.in[I_GBS] = Ap->in[I_GBS]; A.in[I_POOLS] = Ap->in[I_POOLS];
    const float* pscale = A.in[I_POOLS];
    LAS float* lngT = (LAS float*)(F.lds + 65536); LAS float* lnbT = lngT + 1024; LAS float* gbsT = lngT + 2048;
    LAS float* ssaT = (LAS float*)(F.lds + TAB_OFF);
    LAS float* ssbT = (LAS float*)(F.lds + TAB_OFF + 2048);
    LAS float* rab = (LAS float*)(F.lds + TAB_OFF + 6144);
    const int w = F.wave;
    for (int item = F.blk; item < 256; item += F.G) {
        const int lane = lane_id(), tid = w * 64 + lane, fr = lane & 15, fq = lane >> 4;
        const int t0 = 128 * item, tpos0 = t0 & (SEQ - 1);
        unsigned char* wsp = kargs()->ws;
        const bf16* Z = (const bf16*)(wsp + WS_Z); bf16* MIX = (bf16*)(wsp + WS_MIX); const bf16* WSB = (const bf16*)(wsp + WS_WSB); const bf16* PWT = (const bf16*)(wsp + WS_PWT);
        const int wi = w >> 2, wd = w & 3;
        float ssq[4] = {0.f, 0.f, 0.f, 0.f};
        const int li = tid >> 3, cg = tid & 7;
        v4u pre[4];
        { const bf16* zp = Z + (size_t)(t0 + 2 * li) * ZW + 1024 + 16 * cg; pre[0] = *(const v4u*)zp; pre[1] = *(const v4u*)(zp + 8); pre[2] = *(const v4u*)(zp + ZW); pre[3] = *(const v4u*)(zp + ZW + 8); }
        { KArgs ap_ = kargs(); const float* lng_ = ap_->in[I_LNG]; const float* lnb_ = ap_->in[I_LNB]; const float* gbs_ = ap_->in[I_GBS];
          for (int d = tid; d < 1024; d += NTHR) { lngT[d] = lng_[d]; lnbT[d] = lnb_[d]; gbsT[d] = gbs_[d]; } }
        LDS_WAIT(); __syncthreads();
#pragma unroll 1
        for (int h = 0; h < 8; ++h) {
            LAS unsigned* vnT = (LAS unsigned*)(F.lds + (h & 1) * 32768);
            f32x4 sv[8];
            { const int sid = h * 2048 + item * 8 + w, kb = (sid >> 7) & 31, nb = sid & 127, e = 24 + (sid >> 12);
              const float* sp = kargs()->in[I_W1] + (size_t)e * D * 4096 + (unsigned)((64 * kb + 8 * (lane >> 3)) * 4096 + 32 * nb + 4 * (lane & 7));
#pragma unroll
              for (int rr = 0; rr < 8; ++rr) sv[rr] = *(const f32x4*)(sp + rr * 4096); }
            bf16x8 afr[4][4]; v4u uw[4];
            {
                float x0[16], x1[16];
#pragma unroll
                for (int k = 0; k < 4; ++k) { x0[2 * k] = bf_lo(pre[0][k]); x0[2 * k + 1] = bf_hi(pre[0][k]); x0[8 + 2 * k] = bf_lo(pre[1][k]); x0[8 + 2 * k + 1] = bf_hi(pre[1][k]);
                                              x1[2 * k] = bf_lo(pre[2][k]); x1[2 * k + 1] = bf_hi(pre[2][k]); x1[8 + 2 * k] = bf_lo(pre[3][k]); x1[8 + 2 * k + 1] = bf_hi(pre[3][k]); }
                if (h < 7) { const bf16* zp = Z + (size_t)(t0 + 2 * li) * ZW + 1024 + 128 * (h + 1) + 16 * cg; pre[0] = *(const v4u*)zp; pre[1] = *(const v4u*)(zp + 8); pre[2] = *(const v4u*)(zp + ZW); pre[3] = *(const v4u*)(zp + ZW + 8); }
                float s0 = 0.f, s1 = 0.f;
#pragma unroll
                for (int k = 0; k < 16; ++k) { s0 += x0[k]; s1 += x1[k]; }
                s0 += __shfl_xor(s0, 1); s0 += __shfl_xor(s0, 2); s0 += __shfl_xor(s0, 4); s1 += __shfl_xor(s1, 1); s1 += __shfl_xor(s1, 2); s1 += __shfl_xor(s1, 4);
                const float m0 = s0 * (1.0f / 128.0f), m1 = s1 * (1.0f / 128.0f); float q0 = 0.f, q1 = 0.f;
#pragma unroll
                for (int k = 0; k < 16; ++k) { x0[k] -= m0; x1[k] -= m1; q0 += x0[k] * x0[k]; q1 += x1[k] * x1[k]; }
                q0 += __shfl_xor(q0, 1); q0 += __shfl_xor(q0, 2); q0 += __shfl_xor(q0, 4); q1 += __shfl_xor(q1, 1); q1 += __shfl_xor(q1, 2); q1 += __shfl_xor(q1, 4);
                const float r0 = 1.0f / sqrtf(q0 * (1.0f / 128.0f) + LN_EPS), r1 = 1.0f / sqrtf(q1 * (1.0f / 128.0f) + LN_EPS);
                const LAS float* gp = lngT + 128 * h + 16 * cg; const LAS float* bp = lnbT + 128 * h + 16 * cg;
#pragma unroll
                for (int k4 = 0; k4 < 4; ++k4) { const f32x4 g4 = *(const LAS f32x4*)(gp + 4 * k4), b4 = *(const LAS f32x4*)(bp + 4 * k4);
#pragma unroll
                    for (int k = 0; k < 4; ++k) { const int cc = 4 * k4 + k, ch = 16 * cg + cc;
                        const float y0 = x0[cc] * r0 * g4[k] + b4[k], y1 = x1[cc] * r1 * g4[k] + b4[k];
                        vnT[ch * 64 + 4 * ((li >> 2) ^ vsw(ch)) + (li & 3)] = cvt_pk_bf16(y0, y1); } }
            }
            LDS_WAIT(); __syncthreads();
            {
#pragma unroll
                for (int s = 0; s < 4; ++s) uw[s] = *(const v4u*)(Z + (size_t)(t0 + 64 * wi + 16 * s + fr) * ZW + 128 * h + 32 * wd + 8 * fq);
#pragma unroll
                for (int s = 0; s < 4; ++s)
#pragma unroll
                    for (int ks = 0; ks < 4; ++ks) afr[s][ks] = *(const bf16x8*)(WSB + ((size_t)(h * 128 + 64 * wi + 16 * s + fr) * 128 + 32 * ks + 8 * fq));
                bf16x8 bfr[2][4];
#pragma unroll
                for (int t2 = 0; t2 < 2; ++t2)
#pragma unroll
                    for (int ks = 0; ks < 4; ++ks) { const int d = 32 * wd + 8 * (fr >> 2) + 4 * t2 + (fr & 3); bfr[t2][ks] = *(const LAS bf16x8*)(vnT + d * 64 + 4 * ((4 * ks + fq) ^ vsw(d))); }
#pragma unroll
                for (int s = 0; s < 4; ++s) { const int irow = 64 * wi + 16 * s + fr;
                    f32x4 acc[2] = {{0.f, 0.f, 0.f, 0.f}, {0.f, 0.f, 0.f, 0.f}};
#pragma unroll
                    for (int ks = 0; ks < 4; ++ks)
#pragma unroll
                        for (int t2 = 0; t2 < 2; ++t2) acc[t2] = __builtin_amdgcn_mfma_f32_16x16x32_bf16(bfr[t2][ks], afr[s][ks], acc[t2], 0, 0, 0);
                    const float bsv = gbsT[h * 128 + irow];
                    v4u o4;
#pragma unroll
                    for (int t2 = 0; t2 < 2; ++t2) { const unsigned ux = t2 ? uw[s].z : uw[s].x, uy = t2 ? uw[s].w : uw[s].y;
                        const float a0 = bf_lo(ux) * (acc[t2][0] + bsv), a1 = bf_hi(ux) * (acc[t2][1] + bsv), a2 = bf_lo(uy) * (acc[t2][2] + bsv), a3 = bf_hi(uy) * (acc[t2][3] + bsv);
                        ssq[s] += (a0 * a0 + a1 * a1) + (a2 * a2 + a3 * a3);
                        if (t2) { o4.z = cvt_pk_bf16(a0, a1); o4.w = cvt_pk_bf16(a2, a3); } else { o4.x = cvt_pk_bf16(a0, a1); o4.y = cvt_pk_bf16(a2, a3); } }
                    *(v4u*)(MIX + (size_t)(t0 + irow) * D + 128 * h + 32 * wd + 8 * fq) = o4; }
            }
            { const int sid = h * 2048 + item * 8 + w, kb = (sid >> 7) & 31, nb = sid & 127, e = 24 + (sid >> 12);
              const int n0 = 32 * nb, hf = n0 >> 11, j0 = n0 & 2047, n0p = 256 * (j0 >> 7) + 16 * ((j0 & 127) >> 3) + 8 * hf, nq = lane & 7;
              unsigned char* dp = F.ws + WS_W1T + ((size_t)e * 4096 + n0p + 16 * (nq >> 1) + 4 * (nq & 1)) * D + 64 * kb + 8 * (lane >> 3);
#pragma unroll
              for (int c = 0; c < 4; ++c) { v2u o; o.x = pg8::pk_fp8x4(sv[0][c] * pg8::W8_SCALE, sv[1][c] * pg8::W8_SCALE, sv[2][c] * pg8::W8_SCALE, sv[3][c] * pg8::W8_SCALE);
                  o.y = pg8::pk_fp8x4(sv[4][c] * pg8::W8_SCALE, sv[5][c] * pg8::W8_SCALE, sv[6][c] * pg8::W8_SCALE, sv[7][c] * pg8::W8_SCALE); *(v2u*)(dp + (size_t)c * D) = o; } }
        }
#pragma unroll
        for (int s = 0; s < 4; ++s) { float v = ssq[s]; v += __shfl_xor(v, 16); v += __shfl_xor(v, 32); if (fq == 0) ssaT[(64 * wi + 16 * s + fr) * 4 + wd] = v; }
        __syncthreads();
        float ssb[8] = {0.f, 0.f, 0.f, 0.f, 0.f, 0.f, 0.f, 0.f};
#pragma unroll 1
        for (int g = 0; g < 4; ++g) {
            LAS unsigned* poolA = (LAS unsigned*)(F.lds + (g & 1) * 65536);
            pool_stage(Z, t0, tpos0, g, w, lane, poolA);
            LDS_WAIT(); __syncthreads();
            {
                f32x4 acc[8][2];
#pragma unroll
                for (int s = 0; s < 8; ++s) { acc[s][0] = (f32x4){0.f, 0.f, 0.f, 0.f}; acc[s][1] = (f32x4){0.f, 0.f, 0.f, 0.f}; }
#pragma unroll 2
                for (int ks = 0; ks < 8; ++ks) {
                    bf16x8 bfr[2];
#pragma unroll
                    for (int t2 = 0; t2 < 2; ++t2) bfr[t2] = *(const bf16x8*)(PWT + ((size_t)(g * 256 + 32 * w + 8 * (fr >> 2) + 4 * t2 + (fr & 3)) * 256 + 32 * ks + 8 * fq));
#pragma unroll
                    for (int s = 0; s < 8; ++s) { const int t = 16 * s + fr; const bf16x8 afr = *(const LAS bf16x8*)(poolA + t * 128 + 4 * ((4 * ks + fq) ^ (t & 15)));
                        acc[s][0] = __builtin_amdgcn_mfma_f32_16x16x32_bf16(bfr[0], afr, acc[s][0], 0, 0, 0); acc[s][1] = __builtin_amdgcn_mfma_f32_16x16x32_bf16(bfr[1], afr, acc[s][1], 0, 0, 0); }
                }
                { const int dg = 256 * g + 32 * w + 8 * fq; const f32x4 ps0 = *(const f32x4*)(pscale + dg), ps1 = *(const f32x4*)(pscale + dg + 4);
#pragma unroll
                    for (int s = 0; s < 8; ++s) { const int t = 16 * s + fr; const f32x4 y0 = acc[s][0] * ps0, y1 = acc[s][1] * ps1;
                        ssb[s] += ((y0[0] * y0[0] + y0[1] * y0[1]) + (y0[2] * y0[2] + y0[3] * y0[3])) + ((y1[0] * y1[0] + y1[1] * y1[1]) + (y1[2] * y1[2] + y1[3] * y1[3]));
                        v4u o; o.x = cvt_pk_bf16(y0[0], y0[1]); o.y = cvt_pk_bf16(y0[2], y0[3]); o.z = cvt_pk_bf16(y1[0], y1[1]); o.w = cvt_pk_bf16(y1[2], y1[3]); *(v4u*)(MIX + (size_t)(t0 + t) * D + 1024 + dg) = o; } }
            }
        }
#pragma unroll
        for (int s = 0; s < 8; ++s) { float v = ssb[s]; v += __shfl_xor(v, 16); v += __shfl_xor(v, 32); if (fq == 0) ssbT[(16 * s + fr) * 8 + w] = v; }
        LDS_WAIT(); __syncthreads();
        if (tid < 128) { float sa = 0.f, sb = 0.f;
#pragma unroll
            for (int k = 0; k < 4; ++k) sa += ssaT[tid * 4 + k];
#pragma unroll
            for (int k = 0; k < 8; ++k) sb += ssbT[tid * 8 + k];
            ((float*)(F.ws + WS_RA))[t0 + tid] = 1.0f / sqrtf(sa * (1.0f / 1024.0f) + RMS_EPS); ((float*)(F.ws + WS_RB))[t0 + tid] = 1.0f / sqrtf(sb * (1.0f / 1024.0f) + RMS_EPS); }
        __syncthreads();
    }
}

__device__ __forceinline__ void phase5(Frame& F) {
    KArgs Ap = kargs(); struct { const float* in[23]; } A;
    A.in[I_RW] = Ap->in[I_RW]; A.in[I_RB] = Ap->in[I_RB]; A.in[I_FFNG] = Ap->in[I_FFNG];
    const float* w1 = Ap->in[I_W1];
    const float* mod = (const float*)(F.ws + WS_MOD); const bf16* X1 = (const bf16*)(F.ws + WS_X1); unsigned char* H2 = (unsigned char*)(F.ws + WS_H8);
    const float* rwp = (const float*)(F.ws + WS_RWP); const float* rb = A.in[I_RB]; const float* ffng = A.in[I_FFNG];
    float* lgate = (float*)(F.ws + WS_LGATE); int* list = (int*)(F.ws + WS_LIST); unsigned* cnt = (unsigned*)(F.ws + WS_CTL) + CW_CNT;
    LAS float* gsf = (LAS float*)(F.lds + TAB_OFF); LAS float* shf = gsf + D;
    LAS float* part = (LAS float*)(F.lds);
    LAS float* ssp = (LAS float*)(F.lds + 32768);
    LAS int* lcnt = (LAS int*)(F.lds + 32768 + 1024 + 2048);
    LAS int* gbase = lcnt + 32;
    LAS int* ebuf = gbase + 32;
    LAS int* lpos = ebuf + 512;
    LAS float* gbuf = (LAS float*)(lpos + 512);
    const int tid = F.tid, lane = F.lane, w = F.wave, r = lane & 15, q = lane >> 4;
    for (int item = F.blk; item < 256; item += F.G) {
        const int t0 = 128 * item, b = item >> 7;
        __syncthreads();
        for (int d = tid; d < D; d += NTHR) { gsf[d] = ffng[d] * (1.0f + mod[b * 12288 + 4 * D + d]); shf[d] = mod[b * 12288 + 3 * D + d]; }
        if (tid < 32) lcnt[tid] = 0;
        __syncthreads();
        v4u xr[4][2];
        { const bf16* xp = X1 + (size_t)(t0 + r) * D + 256 * w + 16 * q;
#pragma unroll
          for (int s = 0; s < 4; ++s) { xr[s][0] = *(const v4u*)(xp + 64 * s); xr[s][1] = *(const v4u*)(xp + 64 * s + 8); } }
        f32x4 xv[4][4];
#define P5_UNPACK(buf) do { float ss_ = 0.f; _Pragma("unroll") for (int s = 0; s < 4; ++s) _Pragma("unroll") for (int hh = 0; hh < 2; ++hh) { const v4u x = xr[s][hh]; \
            xv[s][2 * hh] = (f32x4){bf_lo(x.x), bf_hi(x.x), bf_lo(x.y), bf_hi(x.y)}; xv[s][2 * hh + 1] = (f32x4){bf_lo(x.z), bf_hi(x.z), bf_lo(x.w), bf_hi(x.w)}; \
            const f32x4 p0 = xv[s][2 * hh], p1 = xv[s][2 * hh + 1]; \
            ss_ += (p0[0] * p0[0] + p0[1] * p0[1]) + (p0[2] * p0[2] + p0[3] * p0[3]) + (p1[0] * p1[0] + p1[1] * p1[1]) + (p1[2] * p1[2] + p1[3] * p1[3]); } \
            ss_ += __shfl_xor(ss_, 16); ss_ += __shfl_xor(ss_, 32); if (q == 0) ssp[(buf) * 128 + w * 16 + r] = ss_; } while (0)
#define P5_LOADX(tokrow) do { const bf16* xp = X1 + (size_t)(tokrow) * D + 256 * w + 16 * q; _Pragma("unroll") for (int s = 0; s < 4; ++s) { xr[s][0] = *(const v4u*)(xp + 64 * s); xr[s][1] = *(const v4u*)(xp + 64 * s + 8); } } while (0)
        P5_UNPACK(0);
        P5_LOADX(t0 + 16 + r);
        LDS_WAIT(); __syncthreads();
#pragma unroll 1
        for (int grp = 0; grp < 8; ++grp) {
            const int tok = t0 + 16 * grp + r, par = grp & 1;
            f32x4 sv[8];
            { const int sid = grp * 2048 + item * 8 + w, kb = (sid >> 7) & 31, nb = sid & 127, e = 28 + (sid >> 12);
              const float* sp = w1 + (size_t)e * D * 4096 + (unsigned)((64 * kb + 8 * (lane >> 3)) * 4096 + 32 * nb + 4 * (lane & 7));
#pragma unroll
              for (int rr = 0; rr < 8; ++rr) sv[rr] = *(const f32x4*)(sp + rr * 4096); }
            float tot = 0.f;
#pragma unroll
            for (int k = 0; k < 8; ++k) tot += ssp[par * 128 + k * 16 + r];
            const float rstd = 1.0f / sqrtf(tot * (1.0f / D) + RMS_EPS);
            unsigned char* hp = H2 + (size_t)tok * D + 256 * w + 16 * q;
#pragma unroll
            for (int s = 0; s < 4; ++s) { const int col = 256 * w + 64 * s + 16 * q; v4u o;
#pragma unroll
                for (int c = 0; c < 4; ++c) { const f32x4 g = *(const LAS f32x4*)(gsf + col + 4 * c), sh4 = *(const LAS f32x4*)(shf + col + 4 * c);
                    xv[s][c] = xv[s][c] * rstd * g + sh4; const unsigned pk = pg8::pk_fp8x4(xv[s][c][0], xv[s][c][1], xv[s][c][2], xv[s][c][3]);
                    if (c == 0) o.x = pk; else if (c == 1) o.y = pk; else if (c == 2) o.z = pk; else o.w = pk; }
                *(v4u*)(hp + 64 * s) = o; }
            f32x4 acc0 = {0.f, 0.f, 0.f, 0.f}, acc1 = {0.f, 0.f, 0.f, 0.f};
            int rwo = w * 8192 + lane * 4; asm volatile("" : "+v"(rwo));
#pragma unroll
            for (int s = 0; s < 4; ++s) {
#pragma unroll
                for (int c = 0; c < 4; ++c) { const f32x4 b0 = *(const f32x4*)(rwp + rwo + (s * 2 + 0) * 1024 + 256 * c), b1 = *(const f32x4*)(rwp + rwo + (s * 2 + 1) * 1024 + 256 * c);
#pragma unroll
                    for (int k = 0; k < 4; ++k) { const float a = xv[s][c][k];
                        acc0 = __builtin_amdgcn_mfma_f32_16x16x4f32(a, b0[k], acc0, 0, 0, 0); acc1 = __builtin_amdgcn_mfma_f32_16x16x4f32(a, b1[k], acc1, 0, 0, 0); } } }
#pragma unroll
            for (int k = 0; k < 4; ++k) { part[par * 4096 + (w * 16 + 4 * q + k) * 32 + r] = acc0[k]; part[par * 4096 + (w * 16 + 4 * q + k) * 32 + 16 + r] = acc1[k]; }
            if (grp < 7) { P5_UNPACK(par ^ 1); if (grp < 6) P5_LOADX(tok + 32); }
            { const int sid = grp * 2048 + item * 8 + w, kb = (sid >> 7) & 31, nb = sid & 127, e = 28 + (sid >> 12);
              const int n0 = 32 * nb, hf = n0 >> 11, j0 = n0 & 2047, n0p = 256 * (j0 >> 7) + 16 * ((j0 & 127) >> 3) + 8 * hf, nq = lane & 7;
              unsigned char* dp = F.ws + WS_W1T + ((size_t)e * 4096 + n0p + 16 * (nq >> 1) + 4 * (nq & 1)) * D + 64 * kb + 8 * (lane >> 3);
#pragma unroll
              for (int c = 0; c < 4; ++c) { v2u o; o.x = pg8::pk_fp8x4(sv[0][c] * pg8::W8_SCALE, sv[1][c] * pg8::W8_SCALE, sv[2][c] * pg8::W8_SCALE, sv[3][c] * pg8::W8_SCALE);
                  o.y = pg8::pk_fp8x4(sv[4][c] * pg8::W8_SCALE, sv[5][c] * pg8::W8_SCALE, sv[6][c] * pg8::W8_SCALE, sv[7][c] * pg8::W8_SCALE); *(v2u*)(dp + (size_t)c * D) = o; } }
            LDS_WAIT(); __syncthreads();
            {
              const int tk = tid >> 5, e = tid & 31; float lg = rb[e];
#pragma unroll
              for (int k = 0; k < 8; ++k) lg += part[par * 4096 + (k * 16 + tk) * 32 + e];
              float val[4]; int idx[4]; float v = lg;
#pragma unroll
              for (int k = 0; k < 4; ++k) { float m = v; int mi = e;
#pragma unroll
                  for (int off = 16; off >= 1; off >>= 1) { const float om = __shfl_xor(m, off); const int oi = __shfl_xor(mi, off); if (om > m || (om == m && oi < mi)) { m = om; mi = oi; } }
                  val[k] = m; idx[k] = mi; if (e == mi) v = -3.0e38f; }
              float ex[4], sum = 0.f;
#pragma unroll
              for (int k = 0; k < 4; ++k) { ex[k] = __expf(val[k] - val[0]); sum += ex[k]; }
              const float inv = 1.0f / sum;
              if (e < 4) { const float gk = (e == 0 ? ex[0] : e == 1 ? ex[1] : e == 2 ? ex[2] : ex[3]) * inv; const int ik = e == 0 ? idx[0] : e == 1 ? idx[1] : e == 2 ? idx[2] : idx[3];
                  const int a = (16 * grp + tk) * 4 + e; gbuf[a] = gk; ebuf[a] = ik; lpos[a] = __hip_atomic_fetch_add(&lcnt[ik], 1, __ATOMIC_RELAXED, __HIP_MEMORY_SCOPE_WORKGROUP); } }
        }
#undef P5_UNPACK
#undef P5_LOADX
        LDS_WAIT(); __syncthreads();
        if (tid < 32) gbase[tid] = (int)__hip_atomic_fetch_add(cnt + 64 * tid, (unsigned)lcnt[tid], __ATOMIC_RELAXED, __HIP_MEMORY_SCOPE_AGENT);
        LDS_WAIT(); __syncthreads();
        { const int e = ebuf[tid]; const size_t li = (size_t)e * LCAP + gbase[e] + lpos[tid]; list[li] = t0 * 4 + tid; lgate[li] = gbuf[tid]; }
    }
}

__device__ __forceinline__ void phase8(Frame& F) {
    KArgs Ap = kargs(); struct { const float* in[23]; float* out; } A;
    A.in[I_FING] = Ap->in[I_FING]; A.out = Ap->out;
    const float* mod = (const float*)(F.ws + WS_MOD); const bf16* X1 = (const bf16*)(F.ws + WS_X1); const unsigned char* Y4 = F.ws + WS_Y4;
    const float* fing = A.in[I_FING]; float* out = A.out;
    LAS float* gfb = (LAS float*)(F.lds); LAS float* fg = gfb + 2 * D;
    __syncthreads();
    for (int d = F.tid; d < 2 * D; d += NTHR) gfb[d] = mod[(d >> 11) * 12288 + 5 * D + (d & (D - 1))] * pg8::Y8_INV;
    for (int d = F.tid; d < D; d += NTHR) fg[d] = fing[d];
    __syncthreads();
    const int gw = F.blk * NWAVES + F.wave, NGW = F.G * NWAVES;
#pragma unroll 1
    for (int tok = gw; tok < T; tok += NGW) { const LAS float* gf = gfb + (tok >= SEQ ? D : 0);
            f32x4 v[2][4]; float ss = 0.f;
            v4u yw[2][4];
#pragma unroll
            for (int j = 0; j < 2; ++j)
#pragma unroll
                for (int k = 0; k < 4; ++k) yw[j][k] = *(const v4u*)(Y4 + ((size_t)tok * 4 + k) * D + 16 * F.lane + 1024 * j);
#pragma unroll
            for (int j = 0; j < 2; ++j)
#pragma unroll
                for (int c2 = 0; c2 < 2; ++c2) { const v4u xw = *(const v4u*)(X1 + (size_t)tok * D + 16 * F.lane + 1024 * j + 8 * c2);
                    v[j][2 * c2] = (f32x4){bf_lo(xw.x), bf_hi(xw.x), bf_lo(xw.y), bf_hi(xw.y)}; v[j][2 * c2 + 1] = (f32x4){bf_lo(xw.z), bf_hi(xw.z), bf_lo(xw.w), bf_hi(xw.w)}; }
#pragma unroll
            for (int j = 0; j < 2; ++j)
#pragma unroll
                for (int c = 0; c < 4; ++c) { f32x4 y = {0.f, 0.f, 0.f, 0.f};
#pragma unroll
                    for (int k = 0; k < 4; ++k) { const f32x2 lo = __builtin_amdgcn_cvt_pk_f32_fp8((int)yw[j][k][c], false), hi = __builtin_amdgcn_cvt_pk_f32_fp8((int)yw[j][k][c], true); y += (f32x4){lo.x, lo.y, hi.x, hi.y}; }
                    const f32x4 g = *(const LAS f32x4*)(gf + 16 * F.lane + 1024 * j + 4 * c);
                    v[j][c] = v[j][c] + g * y;
                    ss += (v[j][c][0] * v[j][c][0] + v[j][c][1] * v[j][c][1]) + (v[j][c][2] * v[j][c][2] + v[j][c][3] * v[j][c][3]); }
            const float rstd = 1.0f / sqrtf(wave_sum(ss) * (1.0f / D) + RMS_EPS);
#pragma unroll
            for (int j = 0; j < 2; ++j)
#pragma unroll
                for (int c = 0; c < 4; ++c) { const int col = 16 * F.lane + 1024 * j + 4 * c;
                    *(f32x4*)(out + (size_t)tok * D + col) = v[j][c] * rstd * *(const LAS f32x4*)(fg + col); } }
}

__global__ void __launch_bounds__(NTHR, 2) mk_fwd(Args args) {
    extern __shared__ __attribute__((aligned(16))) unsigned char lds_raw[];
    Frame F;
    F.lds = (LAS unsigned char*)lds_raw; F.ws = args.ws;
    F.wave = __builtin_amdgcn_readfirstlane((int)threadIdx.x >> 6); F.G = gridDim.x; F.blk = blockIdx.x; F.vblk = F.blk;
#define REFRESH() do { F.lane = lane_id(); F.tid = F.wave * 64 + F.lane; } while (0)
    REFRESH();
    volatile LAS unsigned* MISC = (volatile LAS unsigned*)(F.lds + MISC_OFF);
    if (F.tid < 32) MISC[F.tid] = 0u;
    __syncthreads();
    unsigned* ctl = (unsigned*)(F.ws + WS_CTL);
#if MK_PER_PHASE
#define GRID_BAR() do { } while (0)
#else
    XcdBarrier bar = xcd_barrier_post(ctl + CW_BAR, MISC + 8, F.tid == 0);
#define GRID_BAR() xcd_barrier(bar, F.wave == 0 && lane_id() == 0)
#endif
    const int lo = args.ph_lo, hi = args.ph_hi;
#ifndef PH_MASK
#define PH_MASK 0x1ff
#endif
#define IN(k) (((PH_MASK >> (k)) & 1) && lo <= (k) && (k) < hi)
#define BOTH(k) (IN(k) && IN((k) + 1))
#ifndef REP_MASK
#define REP_MASK 0
#endif
#define REP(k) ((REP_MASK >> (k)) & 1)

    if (IN(0)) { REFRESH(); KArgs Ap = kargs(); phase0(F, Ap->in[I_C], Ap->in[I_WADA]); if (BOTH(0)) GRID_BAR(); if (REP(0)) { phase0(F, Ap->in[I_C], Ap->in[I_WADA]); GRID_BAR(); } }
#if !MK_PER_PHASE
    if (BOTH(0)) { if (F.wave == 0 && lane_id() == 0) { bool even = (F.G % 8) == 0; for (unsigned j = 0; j < 8; ++j) even = even && (xb_ld(&bar.bar[XB_XCNT(j)]) == (unsigned)F.G / 8u); MISC[12] = even ? (bar.x + 8u * MISC[10]) : (unsigned)F.blk; }
        __syncthreads(); F.vblk = (int)MISC[12]; }
#endif
    if (IN(1)) { REFRESH(); phase1(F); if (BOTH(1)) GRID_BAR(); if (REP(1)) { REFRESH(); phase1(F); GRID_BAR(); } }
    if (IN(2)) {
      const bool cv_first = (F.vblk & 1) == 0;
#pragma unroll 1
      for (int st_ = 0; st_ < 3; ++st_) {
        if (st_ == 1) {
          typedef pg8::DenseSched<4096, WS_H, WS_WIN, T / 256, ZW / 256> Sch; Sch S{F.G, F.vblk}; pg8::EpiZ E;
          typedef pg8::AuxW1<21, 3> AX; const int ngw_ = F.G * NWAVES; const AX X{F.blk * NWAVES + F.wave, ngw_, (AX::TOTAL + ngw_ - 1) / ngw_};
          const int done = pg8::gemm_phase<pg8::EpiZ, Sch, true, true, false, AX>(F.lds + RING_OFF, S, E, F.wave, X);
#pragma unroll 1
          for (int j = done; j < X.nsl; ++j) { f32x4 v[8]; const int ln_ = lane_id(); X.issue(v, j, F.wave, ln_); X.consume(v, j, F.wave, ln_); }
        } else if ((st_ == 0) == cv_first) { REFRESH(); convert_big(F, cv_first); __syncthreads(); }
      }
      if (BOTH(2)) GRID_BAR();
    }
    if (IN(3)) { REFRESH(); phase3(F); if (BOTH(3)) GRID_BAR(); if (REP(3)) { REFRESH(); phase3(F); GRID_BAR(); } }
    if (IN(4)) {
#pragma unroll 1
      for (int rp_ = 0; rp_ < (REP(4) ? 2 : 1); ++rp_) {
        typedef pg8::DenseSched<4096, WS_MIX, WS_WOUT, T / 256, D / 256, true> Sch; Sch S{F.G, F.vblk}; pg8::EpiRes E;
        pg8::gemm_phase<pg8::EpiRes, Sch, true, true, false>(F.lds + RING_OFF, S, E, F.wave);
        if (BOTH(4)) GRID_BAR();
      }
    }
    if (IN(5)) { REFRESH(); phase5(F); if (BOTH(5)) GRID_BAR(); }
    if (IN(6) || IN(7)) {
        REFRESH();
        LAS int* tstart = (LAS int*)(F.lds + MOE_OFF); LAS int* ecnt = tstart + 40;
        if (F.tid < 64) { int n = 0; if (F.tid < NE) n = (int)__hip_atomic_load(ctl + CW_CNT + 64 * F.tid, __ATOMIC_RELAXED, __HIP_MEMORY_SCOPE_AGENT);
            int tiles = (n + 255) >> 8, incl = tiles;
#pragma unroll
            for (int o = 1; o < 32; o <<= 1) { const int v = __shfl_up(incl, o); if ((F.tid & 63) >= o) incl += v; }
            if (F.tid < NE) { tstart[F.tid] = incl - tiles; ecnt[F.tid] = n; }
            if (F.tid == NE - 1) tstart[NE] = incl; }
        LDS_WAIT(); __syncthreads();
        const int ntiles = __builtin_amdgcn_readfirstlane(tstart[NE]);
        if (IN(6)) {
          {
            typedef pg8::MoeSched<true, 2048, WS_H8, WS_W1T, (size_t)4096 * D, 16> Sch; Sch S{ntiles, F.G, F.vblk}; pg8::EpiSwiglu E;
            const int ngw_ = F.G * NWAVES; const pg8::AuxW2 X{F.blk * NWAVES + F.wave, ngw_, (pg8::AuxW2::TOTAL + ngw_ - 1) / ngw_};
            const int done = pg8::gemm_phase<pg8::EpiSwiglu, Sch, true, true, true, pg8::AuxW2>(F.lds + RING_OFF, S, E, F.wave, X);
#pragma unroll 1
            for (int j = done; j < X.nsl; ++j) { f32x4 v[8]; const int ln_ = lane_id(); X.issue(v, j, F.wave, ln_); X.consume(v, j, F.wave, ln_); }
            if (BOTH(6)) GRID_BAR();
            if (REP(6)) { pg8::gemm_phase<pg8::EpiSwiglu, Sch, true, true, true>(F.lds + RING_OFF, S, E, F.wave); GRID_BAR(); }
          }
        }
        if (IN(7)) {
          {
            typedef pg8::MoeSched<false, 2048, WS_ACT, WS_W2T, (size_t)D * D, 8> Sch; Sch S{ntiles, F.G, F.vblk}; pg8::EpiY E;
            pg8::gemm_phase<pg8::EpiY, Sch, true, true, true>(F.lds + RING_OFF, S, E, F.wave);
            if (BOTH(7)) GRID_BAR();
            if (REP(7)) { pg8::gemm_phase<pg8::EpiY, Sch, true, true, true>(F.lds + RING_OFF, S, E, F.wave); GRID_BAR(); }
          }
        }
    }
    if (IN(8)) { REFRESH(); phase8(F); if (REP(8)) { GRID_BAR(); REFRESH(); phase8(F); } }
#undef IN
#undef BOTH
}

extern "C" void kernel_launch(void* const* d_in, const int* in_sizes, int n_in, void* d_out, int out_size, void* d_ws, size_t ws_size, hipStream_t stream) {
    static int grid = 0;
    if (grid == 0) {
        if (n_in != 23 || out_size != T * D || ws_size < WS_END) { fprintf(stderr, "kernel_launch: unexpected shapes (n_in %d out %d ws %zu)\n", n_in, out_size, ws_size); grid = -1; return; }
        int dev = 0, cus = 0, per_cu = 0;
        if (hipGetDevice(&dev) != hipSuccess || hipDeviceGetAttribute(&cus, hipDeviceAttributeMultiprocessorCount, dev) != hipSuccess) { grid = -1; return; }
        if (hipFuncSetAttribute((const void*)mk_fwd, hipFuncAttributeMaxDynamicSharedMemorySize, LDS_BYTES) != hipSuccess) { fprintf(stderr, "kernel_launch: hipFuncSetAttribute failed\n"); grid = -1; return; }
        if (hipOccupancyMaxActiveBlocksPerMultiprocessor(&per_cu, (const void*)mk_fwd, NTHR, LDS_BYTES) != hipSuccess || per_cu < 1) fprintf(stderr, "kernel_launch: occupancy query says %d\n", per_cu);
        (void)hipGetLastError();
        grid = cus;
    }
    if (grid < 0) return;
    if (hipMemsetAsync((char*)d_ws + WS_CTL, 0, CTL_ZERO_BYTES, stream) != hipSuccess) return;
    Args a{};
    for (int i = 0; i < 23; ++i) a.in[i] = (const float*)d_in[i];
    a.out = (float*)d_out; a.ws = (unsigned char*)d_ws;
#if MK_PER_PHASE
    for (int ph = 0; ph < 9; ++ph) { a.ph_lo = ph; a.ph_hi = ph + 1; hipLaunchKernelGGL(mk_fwd, dim3(grid), dim3(NTHR), LDS_BYTES, stream, a); }
#else
    a.ph_lo = 0; a.ph_hi = 9; hipLaunchKernelGGL(mk_fwd, dim3(grid), dim3(NTHR), LDS_BYTES, stream, a);
#endif
    (void)in_sizes;
}
```
